# Optimizing an MI355X kernel written in HIP

```python
import math
import jax, jax.numpy as jnp
from jax import lax
import numpy as np

D_MODEL = 1024
BATCH = 16
SEQ = 4096
DEPTH = 1

N_META = 16
D_RNN = D_MODEL
N_RNN_BLOCKS = 8
RNN_BLOCK = D_RNN // N_RNN_BLOCKS
CONV_W = 4
LRU_C = 8.0
N_HEADS = 8
HEAD_DIM = D_MODEL // (2 * N_HEADS)
V_DIM = 2 * HEAD_DIM
ATTN_WIDTH = N_HEADS * V_DIM
QK_WIDTH = N_HEADS * 2 * HEAD_DIM
ROPE_THETA = 10000.0
Q_BLOCK = 128
D_FF = 4 * D_MODEL
EPS = 1e-6
IN_COLS = 2 * D_RNN + 2 * QK_WIDTH + ATTN_WIDTH + 2 * D_MODEL

kernel_name = "hybrid_rglru_diffattn_gated_block"


def _rmsnorm(x, g):
    xf = x.astype(jnp.float32)
    y = xf * lax.rsqrt(jnp.mean(xf * xf, axis=-1, keepdims=True) + EPS)
    return (y * g.astype(jnp.float32)).astype(x.dtype)


def _rope_tables(n_pos):
    inv = 1.0 / (ROPE_THETA ** (jnp.arange(0, HEAD_DIM, 2, dtype=jnp.float32) / HEAD_DIM))
    ang = jnp.arange(n_pos, dtype=jnp.float32)[:, None] * inv[None, :]
    return jnp.cos(ang), jnp.sin(ang)


def _rope(x, cos, sin):
    xf = x.astype(jnp.float32)
    x1, x2 = jnp.split(xf, 2, axis=-1)
    c = cos[None, :, None, None, :]
    s = sin[None, :, None, None, :]
    return jnp.concatenate([x1 * c - x2 * s, x2 * c + x1 * s], axis=-1).astype(x.dtype)


def _rglru_branch(xr, gr, conv_w, conv_b, w_a, b_a, w_x, b_x, lru_lambda):
    B, T, _ = xr.shape
    xf = xr.astype(jnp.float32)
    xpad = jnp.pad(xf, ((0, 0), (CONV_W - 1, 0), (0, 0)))
    xc = conv_b.astype(jnp.float32)
    for k in range(CONV_W):
        xc = xc + conv_w[k].astype(jnp.float32) * xpad[:, k:k + T]
    xb = xc.reshape(B, T, N_RNN_BLOCKS, RNN_BLOCK)
    r = jax.nn.sigmoid(jnp.einsum('btnc,ncd->btnd', xb, w_a.astype(jnp.float32)) + b_a.astype(jnp.float32))
    i = jax.nn.sigmoid(jnp.einsum('btnc,ncd->btnd', xb, w_x.astype(jnp.float32)) + b_x.astype(jnp.float32))
    r = r.reshape(B, T, D_RNN)
    i = i.reshape(B, T, D_RNN)
    log_a = -LRU_C * r * jax.nn.softplus(-lru_lambda.astype(jnp.float32))
    a = jnp.exp(log_a)
    u = jnp.sqrt(-jnp.expm1(2.0 * log_a)) * (i * xc)

    def step(h, inp):
        a_t, u_t = inp
        h = a_t * h + u_t
        return h, h

    h0 = jnp.zeros((B, D_RNN), jnp.float32)
    _, hs = lax.scan(step, h0, (jnp.swapaxes(a, 0, 1), jnp.swapaxes(u, 0, 1)))
    h = jnp.swapaxes(hs, 0, 1)
    y = jax.nn.gelu(gr.astype(jnp.float32)) * h
    return y.astype(xr.dtype)


def _diff_attn_block(q, k, v, q_pos, k_pos, lam):
    scale = 1.0 / math.sqrt(HEAD_DIM)
    s = jnp.einsum('bqhcd,bkhcd->bhcqk', q.astype(jnp.float32), k.astype(jnp.float32)) * scale
    mask = k_pos[None, :] <= q_pos[:, None]
    s = jnp.where(mask[None, None, None], s, jnp.finfo(jnp.float32).min)
    p = jax.nn.softmax(s, axis=-1)
    p_diff = p[:, :, 0] - lam * p[:, :, 1]
    return jnp.einsum('bhqk,bkhe->bqhe', p_diff, v.astype(jnp.float32))


def _diff_attention(q, k, v, lam, lam_init, g_subln, n_real):
    B, T = q.shape[0], q.shape[1]
    pos = jnp.arange(T, dtype=jnp.int32)
    outs = [_diff_attn_block(q[:, :N_META], k[:, :N_META], v[:, :N_META],
                             pos[:N_META], pos[:N_META], lam)]
    for bi in range(n_real // Q_BLOCK):
        start = N_META + bi * Q_BLOCK
        end = start + Q_BLOCK
        outs.append(_diff_attn_block(q[:, start:end], k[:, :end], v[:, :end],
                                     pos[start:end], pos[:end], lam))
    o = jnp.concatenate(outs, axis=1)
    o = o * lax.rsqrt(jnp.mean(o * o, axis=-1, keepdims=True) + EPS) * g_subln.astype(jnp.float32)
    o = o * (1.0 - lam_init)
    return o.reshape(B, T, ATTN_WIDTH).astype(q.dtype)


def setup_inputs(seed: int = 0) -> dict:
    key = jax.random.key(seed)
    ks = jax.random.split(key, 24)
    f32 = jnp.float32
    nrm = lambda k, shape, s: jax.random.normal(k, shape, f32) * s
    u = jax.random.uniform(ks[10], (DEPTH, D_RNN), f32, minval=0.9, maxval=0.999)
    base = u ** (1.0 / LRU_C)
    lru_lambda = jnp.log(base) - jnp.log1p(-base)
    return {
        "x": nrm(ks[0], (BATCH, SEQ, D_MODEL), 1.0),
        "meta_tokens": nrm(ks[1], (N_META, D_MODEL), 1.0),
        "g_mix": 1.0 + nrm(ks[2], (DEPTH, D_MODEL), 0.01),
        "w_in": nrm(ks[3], (DEPTH, D_MODEL, IN_COLS), D_MODEL ** -0.5),
        "conv_w": nrm(ks[4], (DEPTH, CONV_W, D_RNN), CONV_W ** -0.5),
        "conv_b": nrm(ks[5], (DEPTH, D_RNN), 0.01),
        "w_a": nrm(ks[6], (DEPTH, N_RNN_BLOCKS, RNN_BLOCK, RNN_BLOCK), RNN_BLOCK ** -0.5),
        "b_a": nrm(ks[7], (DEPTH, N_RNN_BLOCKS, RNN_BLOCK), 0.01),
        "w_x": nrm(ks[8], (DEPTH, N_RNN_BLOCKS, RNN_BLOCK, RNN_BLOCK), RNN_BLOCK ** -0.5),
        "b_x": nrm(ks[9], (DEPTH, N_RNN_BLOCKS, RNN_BLOCK), 0.01),
        "lru_lambda": lru_lambda,
        "lam_q1": nrm(ks[11], (DEPTH, HEAD_DIM), 0.1),
        "lam_k1": nrm(ks[12], (DEPTH, HEAD_DIM), 0.1),
        "lam_q2": nrm(ks[13], (DEPTH, HEAD_DIM), 0.1),
        "lam_k2": nrm(ks[14], (DEPTH, HEAD_DIM), 0.1),
        "g_subln": 1.0 + nrm(ks[15], (DEPTH, V_DIM), 0.01),
        "w_rnn_out": nrm(ks[16], (DEPTH, D_RNN, D_MODEL), D_RNN ** -0.5),
        "w_attn_out": nrm(ks[17], (DEPTH, ATTN_WIDTH, D_MODEL), ATTN_WIDTH ** -0.5),
        "w_o": nrm(ks[18], (DEPTH, D_MODEL, D_MODEL), D_MODEL ** -0.5),
        "g_mlp": 1.0 + nrm(ks[19], (DEPTH, D_MODEL), 0.01),
        "w_ff1": nrm(ks[20], (DEPTH, D_MODEL, D_FF), D_MODEL ** -0.5),
        "w_ff2": nrm(ks[21], (DEPTH, D_FF, D_MODEL), D_FF ** -0.5),
        "g_final": 1.0 + nrm(ks[22], (D_MODEL,), 0.01),
    }


def reference(x, meta_tokens, g_mix, w_in, conv_w, conv_b, w_a, b_a, w_x, b_x, lru_lambda,
              lam_q1, lam_k1, lam_q2, lam_k2, g_subln, w_rnn_out, w_attn_out, w_o,
              g_mlp, w_ff1, w_ff2, g_final):
    B, S, _ = x.shape
    meta = jnp.broadcast_to(meta_tokens.astype(x.dtype)[None], (B, N_META, D_MODEL))
    h = jnp.concatenate([meta, x], axis=1)
    T = h.shape[1]
    cos, sin = _rope_tables(T)
    c0 = D_RNN
    c1 = c0 + D_RNN
    c2 = c1 + QK_WIDTH
    c3 = c2 + QK_WIDTH
    c4 = c3 + ATTN_WIDTH
    c5 = c4 + D_MODEL
    for l in range(DEPTH):
        hn = _rmsnorm(h, g_mix[l])
        proj = jnp.einsum('btd,dc->btc', hn, w_in[l])
        xr, gr = proj[..., :c0], proj[..., c0:c1]
        q = proj[..., c1:c2].reshape(B, T, N_HEADS, 2, HEAD_DIM)
        k = proj[..., c2:c3].reshape(B, T, N_HEADS, 2, HEAD_DIM)
        v = proj[..., c3:c4].reshape(B, T, N_HEADS, V_DIM)
        gate_r, gate_a = proj[..., c4:c5], proj[..., c5:]

        y_r = _rglru_branch(xr, gr, conv_w[l], conv_b[l], w_a[l], b_a[l], w_x[l], b_x[l], lru_lambda[l])
        y_r = jnp.einsum('btc,cd->btd', y_r, w_rnn_out[l])

        q = _rope(q, cos, sin)
        k = _rope(k, cos, sin)
        lam_init = 0.8 - 0.6 * math.exp(-0.3 * l)
        lam = (jnp.exp(jnp.sum(lam_q1[l].astype(jnp.float32) * lam_k1[l].astype(jnp.float32)))
               - jnp.exp(jnp.sum(lam_q2[l].astype(jnp.float32) * lam_k2[l].astype(jnp.float32)))
               + lam_init)
        y_a = _diff_attention(q, k, v, lam, lam_init, g_subln[l], S)
        y_a = jnp.einsum('btc,cd->btd', y_a, w_attn_out[l])

        merged = jax.nn.sigmoid(gate_r) * y_r + jax.nn.sigmoid(gate_a) * y_a
        h = h + jnp.einsum('btd,de->bte', merged, w_o[l])

        hn2 = _rmsnorm(h, g_mlp[l])
        ff = jnp.square(jax.nn.relu(jnp.einsum('btd,df->btf', hn2, w_ff1[l])))
        h = h + jnp.einsum('btf,fd->btd', ff, w_ff2[l])
    out = _rmsnorm(h, g_final)
    return out[:, N_META:]
```

```cpp
#include <hip/hip_runtime.h>
#include <hip/hip_cooperative_groups.h>
#include <cstdio>
#include <cstdint>
#include <cmath>
namespace cg = cooperative_groups;
namespace pg8 {
#define PG8_LAS __attribute__((address_space(3)))
typedef unsigned short bf16_t;
typedef short bf16x8 __attribute__((ext_vector_type(8)));
typedef float f32x4 __attribute__((ext_vector_type(4)));
typedef unsigned u32x4 __attribute__((ext_vector_type(4)));
constexpr int BM = 256, BK = 64, HALF = 128, HTB = HALF * BK * 2  , STAGE_BYTES = 8 * HTB, NXCD = 8, WGM = 8;

__host__ __device__ __forceinline__ int lds_byte(int r, int c) { const int st = (r >> 4) * 2 + (c >> 5), rr = r & 15, cc = c & 31, ob = rr * 64 + cc * 2; return st * 1024 + (ob ^ (((ob >> 9) & 1) << 5)); }
__host__ __device__ __forceinline__ void stage_rc(int b, int& R, int& C) { const int st = b / 1024, sb = b % 1024, swz = sb ^ (((sb >> 9) & 1) << 5); R = (st >> 1) * 16 + swz / 64; C = (st & 1) * 32 + (swz % 64) / 2; }
__host__ __device__ __forceinline__ int perm32(int rho) { const int n = rho >> 4, i = rho & 15; return 8 * (i >> 2) + 4 * n + (i & 3); }

struct Unit { int pm, pn; };
struct Gemm { const bf16_t* A; const bf16_t* Bt; int M, N, K; };

struct StaticOrder {
    int nM, nN, nwg, G, c;
    __host__ __device__ void init(int M, int N, int G_, int c_) { nM = M / BM; nN = N / BM; nwg = nM * nN; G = G_; c = c_; }
    __host__ __device__ bool next(int i, Unit& u) const {
        const long L = (long)i * G + c; if (L >= nwg) return false;
        int wgid = (int)L; { const int q = nwg / NXCD, r = nwg % NXCD, xcd = wgid % NXCD, off = wgid / NXCD; wgid = (xcd < r ? xcd * (q + 1) : r * (q + 1) + (xcd - r) * q) + off; }
        const int nig = WGM * nN, gid = wgid / nig, fm = gid * WGM, gsz = (nM - fm) < WGM ? (nM - fm) : WGM;
        u.pm = fm + ((wgid % nig) % gsz); u.pn = (wgid % nig) / gsz; return true;
    }
    __device__ __forceinline__ void a_ready(const Unit&) const {}
    __device__ __forceinline__ void done(const Unit&) const {}
};

__device__ __forceinline__ unsigned cvt_pk_bf16(float lo, float hi) { unsigned r; asm volatile("v_cvt_pk_bf16_f32 %0, %1, %2" : "=v"(r) : "v"(lo), "v"(hi)); return r; }
template <class Epi, class Sched, bool ALIGN_EPI = false, bool SP2 = false>
__device__ __forceinline__ void gemm_phase(PG8_LAS unsigned char* lds, const Gemm g, const Sched& S, const Epi& E) {
    const int tid = threadIdx.x, wid = __builtin_amdgcn_readfirstlane(tid >> 6), lane = tid & 63, wr = wid >> 2, wc = wid & 3, fr = lane & 15, fq = lane >> 4;
    const int K = g.K, nt = K / BK;
    unsigned voffA[2], voffB[2];
#pragma unroll
    for (int i = 0; i < 2; ++i) { int R, C; stage_rc(tid * 16 + i * 8192, R, C); const int Rb = Epi::PERM ? ((R & ~31) + perm32(R & 31)) : R;
        voffA[i] = (unsigned)(R * K + C) * 2u; voffB[i] = (unsigned)(Rb * K + C) * 2u; }
    const size_t kstep = (size_t)(BK * 2);
    const size_t hstep = (size_t)HALF * K * 2;
    const size_t tstep = 2 * hstep;
    const unsigned ldsw = (unsigned)wid * 1024u;
    const int aoff = lds_byte(wr * 64 + fr, fq * 8), boff = lds_byte(wc * 32 + fr, fq * 8);
#define PG8_SA(b, h) (((b) * 2 + (h)) * HTB)
#define PG8_SB(b, h) ((4 + (b) * 2 + (h)) * HTB)
#define PG8_STAGE(bufoff, gbase, voff) do { _Pragma("unroll") for (int _i = 0; _i < 2; ++_i) \
        __builtin_amdgcn_global_load_lds((const unsigned*)((const char*)(gbase) + (voff)[_i]), (PG8_LAS unsigned*)(lds + (bufoff) + ldsw + _i * 8192), 16, 0, 0); } while (0)
#define PG8_LDA(dst, b, h) do { _Pragma("unroll") for (int m = 0; m < 4; ++m) _Pragma("unroll") for (int k = 0; k < 2; ++k) dst[m][k] = *(const PG8_LAS bf16x8*)(lds + PG8_SA(b, h) + aoff + m * 2048 + k * 1024); } while (0)
#define PG8_LDB(dst, b, h) do { _Pragma("unroll") for (int n = 0; n < 2; ++n) _Pragma("unroll") for (int k = 0; k < 2; ++k) dst[n][k] = *(const PG8_LAS bf16x8*)(lds + PG8_SB(b, h) + boff + n * 2048 + k * 1024); } while (0)
#define PG8_MMA(ai, bj, At, Bt) do { __builtin_amdgcn_s_setprio(1); _Pragma("unroll") for (int m = 0; m < 4; ++m) _Pragma("unroll") for (int n = 0; n < 2; ++n) _Pragma("unroll") for (int k = 0; k < 2; ++k) \
        acc[ai][bj][m][n] = __builtin_amdgcn_mfma_f32_16x16x32_bf16(Bt[n][k], At[m][k], acc[ai][bj][m][n], 0, 0, 0); __builtin_amdgcn_s_setprio(0); } while (0)
#define PG8_WAIT_V(n) asm volatile("s_waitcnt vmcnt(" #n ")" ::: "memory")
#define PG8_WAIT_L(n) asm volatile("s_waitcnt lgkmcnt(" #n ")" ::: "memory")
#define PG8_BAR __builtin_amdgcn_s_barrier()
#define PG8_SCHED __builtin_amdgcn_sched_barrier(0)
    Unit cur, nxt; int ui = 0;
    if (!S.next(0, cur)) return;
    f32x4 acc[2][2][4][2];
#pragma unroll
    for (int a = 0; a < 2; ++a)
#pragma unroll
        for (int b = 0; b < 2; ++b)
#pragma unroll
            for (int m = 0; m < 4; ++m)
#pragma unroll
                for (int n = 0; n < 2; ++n) acc[a][b][m][n] = (f32x4){0.f, 0.f, 0.f, 0.f};
    bf16x8 At[4][2], B0[2][2], B1[2][2];
    const char* cA = (const char*)g.A + (size_t)cur.pm * tstep; const char* cB = (const char*)g.Bt + (size_t)cur.pn * tstep;
    S.a_ready(cur);
    if constexpr (SP2) {
        PG8_STAGE(PG8_SB(0, 0), cB, voffB); PG8_STAGE(PG8_SB(0, 1), cB + hstep, voffB); PG8_STAGE(PG8_SA(0, 0), cA, voffA); PG8_STAGE(PG8_SA(0, 1), cA + hstep, voffA);
        if (wr == 1) PG8_BAR;
        PG8_WAIT_V(2); PG8_BAR;
        PG8_STAGE(PG8_SB(1, 0), cB + kstep, voffB); PG8_STAGE(PG8_SA(1, 0), cA + kstep, voffA); PG8_STAGE(PG8_SB(1, 1), cB + hstep + kstep, voffB);
        PG8_WAIT_V(6); PG8_BAR;
    } else {
        PG8_STAGE(PG8_SB(0, 0), cB, voffB); PG8_STAGE(PG8_SA(0, 0), cA, voffA); PG8_STAGE(PG8_SB(0, 1), cB + hstep, voffB); PG8_STAGE(PG8_SA(0, 1), cA + hstep, voffA);
        if (wr == 1) PG8_BAR;
        PG8_WAIT_V(4); PG8_BAR;
        PG8_STAGE(PG8_SB(1, 0), cB + kstep, voffB); PG8_STAGE(PG8_SA(1, 0), cA + kstep, voffA); PG8_STAGE(PG8_SB(1, 1), cB + hstep + kstep, voffB);
        PG8_WAIT_V(6); PG8_BAR;
    }
    for (;;) {
        const bool has_next = S.next(ui + 1, nxt);
        const char* nA = has_next ? (const char*)g.A + (size_t)nxt.pm * tstep : cA; const char* nB = has_next ? (const char*)g.Bt + (size_t)nxt.pn * tstep : cB;
        for (int t = 0; t < nt; t += 2) {
            if constexpr (Epi::HAS_MID) { if (t == (nt >> 1)) E.mid(acc, cur, wr, wc, fr, fq); }
            const bool last = (t == nt - 2);
            const char* a1 = cA + (size_t)(t + 1) * kstep;
            const char* a2 = last ? nA : cA + (size_t)(t + 2) * kstep; const char* b2 = last ? nB : cB + (size_t)(t + 2) * kstep;
            const char* a3 = a2 + kstep; const char* b3 = b2 + kstep;
            if (last && has_next) S.a_ready(nxt);
            if constexpr (SP2) {
            PG8_LDB(B0, 0, 0); PG8_LDB(B1, 0, 1); PG8_SCHED; PG8_LDA(At, 0, 0); PG8_STAGE(PG8_SA(1, 1), a1 + hstep, voffA);
            PG8_WAIT_V(8); PG8_WAIT_L(0); PG8_BAR; PG8_MMA(0, 0, At, B0); PG8_MMA(0, 1, At, B1); PG8_BAR; PG8_SCHED;
            PG8_LDA(At, 0, 1); PG8_STAGE(PG8_SB(0, 0), b2, voffB); PG8_STAGE(PG8_SB(0, 1), b2 + hstep, voffB); PG8_STAGE(PG8_SA(0, 0), a2, voffA);
            PG8_WAIT_V(8); PG8_WAIT_L(0); PG8_BAR; PG8_MMA(1, 0, At, B0); PG8_MMA(1, 1, At, B1); PG8_BAR; PG8_SCHED;
            PG8_LDB(B0, 1, 0); PG8_LDB(B1, 1, 1); PG8_SCHED; PG8_LDA(At, 1, 0); PG8_STAGE(PG8_SA(0, 1), a2 + hstep, voffA);
            PG8_WAIT_V(8); PG8_WAIT_L(0); PG8_BAR; PG8_MMA(0, 0, At, B0); PG8_MMA(0, 1, At, B1); PG8_BAR; PG8_SCHED;
            PG8_LDA(At, 1, 1); PG8_STAGE(PG8_SB(1, 0), b3, voffB); PG8_STAGE(PG8_SB(1, 1), b3 + hstep, voffB); PG8_STAGE(PG8_SA(1, 0), a3, voffA);
            PG8_WAIT_V(8); PG8_WAIT_L(0); PG8_BAR; PG8_MMA(1, 0, At, B0); PG8_MMA(1, 1, At, B1); PG8_BAR; PG8_SCHED;
            } else {
            PG8_LDB(B0, 0, 0); PG8_SCHED; PG8_LDA(At, 0, 0); PG8_STAGE(PG8_SA(1, 1), a1 + hstep, voffA);
            PG8_WAIT_L(8); PG8_BAR; PG8_WAIT_L(0); PG8_MMA(0, 0, At, B0); PG8_BAR; PG8_SCHED;
            PG8_LDB(B1, 0, 1); PG8_STAGE(PG8_SB(0, 0), b2, voffB);
            PG8_BAR; PG8_WAIT_L(0); PG8_MMA(0, 1, At, B1); PG8_BAR;
            PG8_LDA(At, 0, 1); PG8_STAGE(PG8_SA(0, 0), a2, voffA);
            PG8_BAR; PG8_WAIT_L(0); PG8_MMA(1, 0, At, B0); PG8_BAR; PG8_SCHED;
            PG8_STAGE(PG8_SB(0, 1), b2 + hstep, voffB);
            PG8_WAIT_V(6); PG8_BAR; PG8_MMA(1, 1, At, B1); PG8_BAR;
            PG8_LDB(B0, 1, 0); PG8_SCHED; PG8_LDA(At, 1, 0); PG8_STAGE(PG8_SA(0, 1), a2 + hstep, voffA);
            PG8_WAIT_L(8); PG8_BAR; PG8_WAIT_L(0); PG8_MMA(0, 0, At, B0); PG8_BAR; PG8_SCHED;
            PG8_LDB(B1, 1, 1); PG8_STAGE(PG8_SB(1, 0), b3, voffB);
            PG8_BAR; PG8_WAIT_L(0); PG8_MMA(0, 1, At, B1); PG8_BAR;
            PG8_LDA(At, 1, 1); PG8_STAGE(PG8_SA(1, 0), a3, voffA);
            PG8_BAR; PG8_WAIT_L(0); PG8_MMA(1, 0, At, B0); PG8_BAR; PG8_SCHED;
            PG8_STAGE(PG8_SB(1, 1), b3 + hstep, voffB);
            PG8_WAIT_V(6); PG8_BAR; PG8_MMA(1, 1, At, B1); PG8_BAR;
            }
        }
        if constexpr (ALIGN_EPI) { if (wr == 0) PG8_BAR; }
        if constexpr (!Epi::AFTER_DRAIN) { E(acc, cur, wr, wc, fr, fq); S.done(cur); }
        if (!has_next) break;
#pragma unroll
        for (int a = 0; a < 2; ++a)
#pragma unroll
            for (int b = 0; b < 2; ++b)
#pragma unroll
                for (int m = 0; m < 4; ++m)
#pragma unroll
                    for (int n = 0; n < 2; ++n) acc[a][b][m][n] = (f32x4){0.f, 0.f, 0.f, 0.f};
        cur = nxt; cA = nA; cB = nB; ++ui;
        if constexpr (ALIGN_EPI) { if (wr == 1) PG8_BAR; }
    }
    PG8_WAIT_V(0);
    if constexpr (!ALIGN_EPI) { if (wr == 0) PG8_BAR; }
    PG8_BAR;
    if constexpr (Epi::AFTER_DRAIN) { E.fused(acc, cur, wr, wc, fr, fq, lds, wid, lane); S.done(cur); }
#undef PG8_SA
#undef PG8_SB
#undef PG8_STAGE
#undef PG8_LDA
#undef PG8_LDB
#undef PG8_MMA
#undef PG8_WAIT_V
#undef PG8_WAIT_L
#undef PG8_BAR
#undef PG8_SCHED
}
}
using pg8::bf16_t; using pg8::bf16x8; using pg8::f32x4; using pg8::u32x4; using pg8::Unit;
#define LAS __attribute__((address_space(3)))
typedef float f32x16 __attribute__((ext_vector_type(16)));
typedef unsigned u32x2 __attribute__((ext_vector_type(2)));
typedef short v4i16_t __attribute__((ext_vector_type(4)));

constexpr int NB = 16, SEQ = 4096, DM = 1024, NMETA = 16, MREAL = NB * SEQ  , MTOT = MREAL + 256  , NPOS = SEQ + NMETA  ;
constexpr int INCOLS = 7168, DFF = 4096;
constexpr float EPS = 1e-6f;
constexpr float C2 = 0.125f * 1.4426950408889634f;
constexpr size_t MiB = 1u << 20;
constexpr size_t WS_CTL = 0;
constexpr size_t WS_COS = 1 * MiB, WS_SIN = 2 * MiB;
constexpr size_t WS_PART1 = 3 * MiB, WS_PART2 = 7 * MiB;
constexpr size_t WS_WIN = 12 * MiB, WS_WRNN = 26 * MiB, WS_WATT = 28 * MiB, WS_WO = 30 * MiB, WS_W1 = 32 * MiB, WS_W2 = 40 * MiB, WS_WG = 48 * MiB;
constexpr size_t WS_SEG = 50 * MiB, SEG_BYTES = 129 * MiB, SEG_ELEMS = SEG_BYTES / 2;
constexpr size_t WS_END = WS_SEG + 7 * SEG_BYTES;
constexpr int LDS_BYTES = 147456, MISC_OFF = 131072 + 320;

__device__ const float INV_FREQ[32] = {1.000000000e+00f,7.498942018e-01f,5.623413324e-01f,4.216965139e-01f,3.162277639e-01f,2.371373922e-01f,1.778279394e-01f,1.333521456e-01f,1.000000015e-01f,7.498941571e-02f,5.623412877e-02f,4.216964915e-02f,3.162277862e-02f,2.371373586e-02f,1.778279431e-02f,1.333521493e-02f,9.999999776e-03f,7.498942316e-03f,5.623413250e-03f,4.216964822e-03f,3.162277862e-03f,2.371373819e-03f,1.778279431e-03f,1.333521446e-03f,1.000000047e-03f,7.498941850e-04f,5.623413017e-04f,4.216965463e-04f,3.162277862e-04f,2.371373848e-04f,1.778279402e-04f,1.333521504e-04f};

__device__ __forceinline__ unsigned f2bf(float f) { unsigned u = __builtin_bit_cast(unsigned, f); return (u + 0x7fffu + ((u >> 16) & 1u)) >> 16; }
typedef float f32x2_t __attribute__((ext_vector_type(2))); typedef __bf16 bf16x2_t __attribute__((ext_vector_type(2)));
__device__ __forceinline__ unsigned pk2(float lo, float hi) { f32x2_t v = {lo, hi}; bf16x2_t b = __builtin_convertvector(v, bf16x2_t); return __builtin_bit_cast(unsigned, b); }
__device__ __forceinline__ float bflo(unsigned w) { return __uint_as_float(w << 16); }
__device__ __forceinline__ float bfhi(unsigned w) { return __uint_as_float(w & 0xffff0000u); }
__device__ __forceinline__ float fsigmoid(float x) { return __builtin_amdgcn_rcpf(1.0f + __builtin_amdgcn_exp2f(-1.4426950408889634f * x)); }
__device__ __forceinline__ float gelu_tanh(float x) { const float z = 1.5957691216057308f * (x + 0.044715f * x * x * x); return x * fsigmoid(z); }
__device__ __forceinline__ float wave_sum(float v) {
#pragma unroll
    for (int o = 1; o < 64; o <<= 1) v += __shfl_xor(v, o);
    return v;
}
#define MEMFENCE() asm volatile("" ::: "memory")

struct EpiProj {
    static constexpr bool PERM = true, AFTER_DRAIN = false, HAS_MID = false;
    bf16_t* seg0; const float* cosT; const float* sinT;
    __device__ __forceinline__ void operator()(const f32x4 (&acc)[2][2][4][2], const Unit& u, int wr, int wc, int fr, int fq) const {
        const int seg = u.pn >> 2, colt = (u.pn & 3) * 256;
        bf16_t* base = seg0 + (size_t)seg * SEG_ELEMS;
        const int col0 = colt + wc * 32 + 8 * fq, row0 = u.pm * 256 + wr * 64 + fr;
        if (seg == 2 || seg == 3) {
            const float sc = (seg == 2) ? C2 : 1.0f;
            const int fi = 4 * (4 * (wc & 1) + fq);
#pragma unroll
            for (int ai = 0; ai < 2; ++ai)
#pragma unroll
                for (int m = 0; m < 4; ++m) {
                    const int row = row0 + ai * 128 + m * 16;
                    int pos = row < MREAL ? NMETA + (row & (SEQ - 1)) : row - MREAL; pos = pos < NPOS ? pos : NPOS - 1;
                    const f32x4 cs = *(const f32x4*)(cosT + pos * 32 + fi), sn = *(const f32x4*)(sinT + pos * 32 + fi);
                    bf16_t* rowp = base + (size_t)row * DM + col0;
#pragma unroll
                    for (int bj = 0; bj < 2; ++bj) {
                        const f32x4 v0 = acc[ai][bj][m][0], v1 = acc[ai][bj][m][1];
                        const f32x4 o0 = (v0 * cs - v1 * sn) * sc, o1 = (v1 * cs + v0 * sn) * sc;
                        u32x4 w; w.x = pk2(o0[0], o0[1]); w.y = pk2(o0[2], o0[3]); w.z = pk2(o1[0], o1[1]); w.w = pk2(o1[2], o1[3]);
                        *(u32x4*)(rowp + bj * 128) = w;
                    }
                    if (m & 1) MEMFENCE();
                }
        } else {
            const int mode = (seg == 1) ? 1 : (seg >= 5 ? 2 : 0);
#pragma unroll
            for (int ai = 0; ai < 2; ++ai)
#pragma unroll
                for (int m = 0; m < 4; ++m) {
                    const int row = row0 + ai * 128 + m * 16;
                    bf16_t* rowp = base + (size_t)row * DM + col0;
#pragma unroll
                    for (int bj = 0; bj < 2; ++bj) {
                        f32x4 v0 = acc[ai][bj][m][0], v1 = acc[ai][bj][m][1];
                        if (mode == 1) {
#pragma unroll
                            for (int i = 0; i < 4; ++i) { v0[i] = gelu_tanh(v0[i]); v1[i] = gelu_tanh(v1[i]); }
                        } else if (mode == 2) {
#pragma unroll
                            for (int i = 0; i < 4; ++i) { v0[i] = fsigmoid(v0[i]); v1[i] = fsigmoid(v1[i]); }
                        }
                        u32x4 w; w.x = pk2(v0[0], v0[1]); w.y = pk2(v0[2], v0[3]); w.z = pk2(v1[0], v1[1]); w.w = pk2(v1[2], v1[3]);
                        *(u32x4*)(rowp + bj * 128) = w;
                    }
                }
        }
    }
};
struct EpiMerge {
    static constexpr bool PERM = true, AFTER_DRAIN = false, HAS_MID = true;
    bf16_t* out; const bf16_t* gr; const bf16_t* ga;
    __device__ __forceinline__ void mid(f32x4 (&acc)[2][2][4][2], const Unit& u, int wr, int wc, int fr, int fq) const {
        int col0 = u.pn * 256 + wc * 32 + 8 * fq, row0 = u.pm * 256 + wr * 64 + fr;
        asm volatile("" : "+v"(col0), "+v"(row0));
#pragma unroll
        for (int ai = 0; ai < 2; ++ai)
#pragma unroll
            for (int m = 0; m < 4; ++m) {
                const size_t off = (size_t)(row0 + ai * 128 + m * 16) * DM + col0;
#pragma unroll
                for (int bj = 0; bj < 2; ++bj) {
                    const u32x4 r = __builtin_nontemporal_load((const u32x4*)(gr + off + bj * 128)), a = *(const u32x4*)(ga + off + bj * 128);
                    const unsigned rw[4] = {r.x, r.y, r.z, r.w}, aw[4] = {a.x, a.y, a.z, a.w};
#pragma unroll
                    for (int i = 0; i < 4; ++i) {
                        const float q0 = bflo(rw[i]) * __builtin_amdgcn_rcpf(fmaxf(bflo(aw[i]), 1e-30f)), q1 = bfhi(rw[i]) * __builtin_amdgcn_rcpf(fmaxf(bfhi(aw[i]), 1e-30f));
                        acc[ai][bj][m][i >> 1][2 * (i & 1)] *= q0; acc[ai][bj][m][i >> 1][2 * (i & 1) + 1] *= q1;
                    }
                }
                MEMFENCE();
            }
    }
    __device__ __forceinline__ void operator()(const f32x4 (&acc)[2][2][4][2], const Unit& u, int wr, int wc, int fr, int fq) const {
        const int col0 = u.pn * 256 + wc * 32 + 8 * fq, row0 = u.pm * 256 + wr * 64 + fr;
#pragma unroll
        for (int ai = 0; ai < 2; ++ai)
#pragma unroll
            for (int m = 0; m < 4; ++m) {
                const size_t off = (size_t)(row0 + ai * 128 + m * 16) * DM + col0;
#pragma unroll
                for (int bj = 0; bj < 2; ++bj) {
                    const u32x4 g = *(const u32x4*)(ga + off + bj * 128);
                    f32x4 v0 = acc[ai][bj][m][0], v1 = acc[ai][bj][m][1];
                    v0[0] *= bflo(g.x); v0[1] *= bfhi(g.x); v0[2] *= bflo(g.y); v0[3] *= bfhi(g.y);
                    v1[0] *= bflo(g.z); v1[1] *= bfhi(g.z); v1[2] *= bflo(g.w); v1[3] *= bfhi(g.w);
                    u32x4 w; w.x = pk2(v0[0], v0[1]); w.y = pk2(v0[2], v0[3]); w.z = pk2(v1[0], v1[1]); w.w = pk2(v1[2], v1[3]);
                    *(u32x4*)(out + off + bj * 128) = w;
                }
                MEMFENCE();
            }
    }
};
template <bool FIRST> struct EpiRes {
    static constexpr bool PERM = true, AFTER_DRAIN = false, HAS_MID = false;
    const float* basef; const bf16_t* baseh; bf16_t* out; bf16_t* hn; const float* g; float* part;
    __device__ __forceinline__ void operator()(const f32x4 (&acc)[2][2][4][2], const Unit& u, int wr, int wc, int fr, int fq) const {
        const int col0 = u.pn * 256 + wc * 32 + 8 * fq, row0 = u.pm * 256 + wr * 64 + fr;
#pragma unroll
        for (int ai = 0; ai < 2; ++ai)
#pragma unroll
            for (int m = 0; m < 4; ++m) {
                const int row = row0 + ai * 128 + m * 16; const size_t off = (size_t)row * DM + col0;
                float ss = 0.f;
#pragma unroll
                for (int bj = 0; bj < 2; ++bj) {
                    f32x4 h0, h1;
                    if (FIRST) { h0 = __builtin_nontemporal_load((const f32x4*)(basef + off + bj * 128)); h1 = __builtin_nontemporal_load((const f32x4*)(basef + off + bj * 128 + 4)); }
                    else { const u32x4 p = __builtin_nontemporal_load((const u32x4*)(baseh + off + bj * 128)); h0 = (f32x4){bflo(p.x), bfhi(p.x), bflo(p.y), bfhi(p.y)}; h1 = (f32x4){bflo(p.z), bfhi(p.z), bflo(p.w), bfhi(p.w)}; }
                    h0 += acc[ai][bj][m][0]; h1 += acc[ai][bj][m][1];
                    u32x4 w; w.x = pk2(h0[0], h0[1]); w.y = pk2(h0[2], h0[3]); w.z = pk2(h1[0], h1[1]); w.w = pk2(h1[2], h1[3]);
                    if (FIRST) __builtin_nontemporal_store(w, (u32x4*)(out + off + bj * 128)); else *(u32x4*)(out + off + bj * 128) = w;
                    ss += (h0[0] * h0[0] + h0[1] * h0[1]) + (h0[2] * h0[2] + h0[3] * h0[3]) + (h1[0] * h1[0] + h1[1] * h1[1]) + (h1[2] * h1[2] + h1[3] * h1[3]);
                    if (FIRST) {
                        const f32x4 g0 = *(const f32x4*)(g + col0 + bj * 128), g1 = *(const f32x4*)(g + col0 + bj * 128 + 4);
                        const f32x4 a = h0 * g0, b = h1 * g1;
                        u32x4 w2; w2.x = pk2(a[0], a[1]); w2.y = pk2(a[2], a[3]); w2.z = pk2(b[0], b[1]); w2.w = pk2(b[2], b[3]);
                        *(u32x4*)(hn + off + bj * 128) = w2;
                    }
                }
                ss += __shfl_xor(ss, 16); ss += __shfl_xor(ss, 32);
                if (fq == 0) part[(size_t)row * 16 + u.pn * 4 + wc] = ss;
                MEMFENCE();
            }
    }
};
struct EpiFF1 {
    static constexpr bool PERM = true, AFTER_DRAIN = false, HAS_MID = false;
    bf16_t* ff; const float* part;
    __device__ __forceinline__ void operator()(const f32x4 (&acc)[2][2][4][2], const Unit& u, int wr, int wc, int fr, int fq) const {
        const int col0 = u.pn * 256 + wc * 32 + 8 * fq, row0 = u.pm * 256 + wr * 64 + fr;
#pragma unroll
        for (int ai = 0; ai < 2; ++ai)
#pragma unroll
            for (int m = 0; m < 4; ++m) {
                const int row = row0 + ai * 128 + m * 16;
                const f32x4* pp = (const f32x4*)(part + (size_t)row * 16);
                const f32x4 p0 = pp[0], p1 = pp[1], p2 = pp[2], p3 = pp[3];
                const float s = ((p0[0] + p0[1]) + (p0[2] + p0[3])) + ((p1[0] + p1[1]) + (p1[2] + p1[3])) + ((p2[0] + p2[1]) + (p2[2] + p2[3])) + ((p3[0] + p3[1]) + (p3[2] + p3[3]));
                const float rstd = __builtin_amdgcn_rsqf(s * (1.0f / DM) + EPS);
                bf16_t* rowp = ff + (size_t)row * DFF + col0;
#pragma unroll
                for (int bj = 0; bj < 2; ++bj) {
                    f32x4 v0 = acc[ai][bj][m][0] * rstd, v1 = acc[ai][bj][m][1] * rstd;
#pragma unroll
                    for (int i = 0; i < 4; ++i) { v0[i] = fmaxf(v0[i], 0.f); v0[i] *= v0[i]; v1[i] = fmaxf(v1[i], 0.f); v1[i] *= v1[i]; }
                    u32x4 w; w.x = pk2(v0[0], v0[1]); w.y = pk2(v0[2], v0[3]); w.z = pk2(v1[0], v1[1]); w.w = pk2(v1[2], v1[3]);
                    __builtin_nontemporal_store(w, (u32x4*)(rowp + bj * 128));
                }
                if (m & 1) MEMFENCE();
            }
    }
};

struct Ctx {
    const float* in[23]; float* out; unsigned char* ws;
};
struct Args { const float* in[23]; float* out; unsigned char* ws; int mask; int pad; };

__device__ __forceinline__ void p0_transpose_item(const float* W, int K, int N, bf16_t* WT, int perm_lo, int perm_hi, LAS float* scr, int item, int lane, int ldk = 0) {
    if (ldk == 0) ldk = K;
    const int nblk = N / 32, kb = item / nblk, nb = item % nblk, k0 = 64 * kb, n0 = 32 * nb;
#pragma unroll 8
    for (int i = 0; i < 32; ++i) { const int kk = 2 * i + (lane >> 5); scr[kk * 33 + (lane & 31)] = W[(size_t)(k0 + kk) * N + n0 + (lane & 31)]; }
    asm volatile("s_waitcnt lgkmcnt(0)" ::: "memory");
    const int c = lane & 7;
#pragma unroll
    for (int j = 0; j < 4; ++j) { const int n = (lane >> 3) + 8 * j; const LAS float* s = scr + (8 * c) * 33 + n;
        u32x4 o; o.x = f2bf(s[0 * 33]) | (f2bf(s[1 * 33]) << 16); o.y = f2bf(s[2 * 33]) | (f2bf(s[3 * 33]) << 16); o.z = f2bf(s[4 * 33]) | (f2bf(s[5 * 33]) << 16); o.w = f2bf(s[6 * 33]) | (f2bf(s[7 * 33]) << 16);
        int nl = n0 + n;
        if (nl >= perm_lo && nl < perm_hi) { const int jj = nl & 63; const int gg = (jj < 32) ? (8 * (jj >> 2) + (jj & 3)) : (8 * ((jj - 32) >> 2) + 4 + (jj & 3)); nl = (nl & ~63) + gg; }
        *(u32x4*)(WT + (size_t)nl * ldk + k0 + 8 * c) = o; }
    asm volatile("s_waitcnt lgkmcnt(0)" ::: "memory");
}
__device__ __forceinline__ void rms_row_to_bf16(const float* xrow, const float* g, bf16_t* orow, int lane) {
    const f32x4* xr = (const f32x4*)xrow + lane; const f32x4* gr = (const f32x4*)g + lane;
    f32x4 v[4]; float s = 0.f;
#pragma unroll
    for (int j = 0; j < 4; ++j) { v[j] = __builtin_nontemporal_load(xr + 64 * j); s += (v[j][0] * v[j][0] + v[j][1] * v[j][1]) + (v[j][2] * v[j][2] + v[j][3] * v[j][3]); }
    const float rstd = 1.0f / sqrtf(wave_sum(s) * (1.0f / DM) + EPS);
    u32x2* o8 = (u32x2*)orow + lane;
#pragma unroll
    for (int j = 0; j < 4; ++j) { const f32x4 gg = gr[64 * j]; u32x2 w; w.x = pk2(v[j][0] * rstd * gg[0], v[j][1] * rstd * gg[1]); w.y = pk2(v[j][2] * rstd * gg[2], v[j][3] * rstd * gg[3]); o8[64 * j] = w; }
}
__device__ __forceinline__ void p0_prologue(const Args& A, LAS unsigned char* lds, int tid, int lane, int wave) {
    unsigned char* ws = A.ws;
    LAS float* scr = (LAS float*)(lds + wave * 16384);
    const int gw = blockIdx.x * 8 + wave, NGW = gridDim.x * 8;
    constexpr int I_IN = 16 * (INCOLS / 32), I_SQ = 16 * 32, I_1 = 16 * (DFF / 32), I_2 = (DFF / 64) * 32, I_G = 16 * 8;
    constexpr int NITEMS = I_IN + 3 * I_SQ + I_1 + I_2 + I_G;
    for (int it = gw; it < NITEMS; it += NGW) {
        int r = it;
        if (r < I_IN) { p0_transpose_item(A.in[3], DM, INCOLS, (bf16_t*)(ws + WS_WIN), 2048, 4096, scr, r, lane); continue; } r -= I_IN;
        if (r < I_SQ) { p0_transpose_item(A.in[16], DM, DM, (bf16_t*)(ws + WS_WRNN), 0, 0, scr, r, lane, 2 * DM); continue; } r -= I_SQ;
        if (r < I_SQ) { p0_transpose_item(A.in[17], DM, DM, (bf16_t*)(ws + WS_WRNN) + DM, 0, 0, scr, r, lane, 2 * DM); continue; } r -= I_SQ;
        if (r < I_SQ) { p0_transpose_item(A.in[18], DM, DM, (bf16_t*)(ws + WS_WO), 0, 0, scr, r, lane); continue; } r -= I_SQ;
        if (r < I_1) { p0_transpose_item(A.in[20], DM, DFF, (bf16_t*)(ws + WS_W1), 0, 0, scr, r, lane); continue; } r -= I_1;
        if (r < I_2) { p0_transpose_item(A.in[21], DFF, DM, (bf16_t*)(ws + WS_W2), 0, 0, scr, r, lane); continue; } r -= I_2;
        { const int blk = r >> 3, sub = r & 7;
          const int gate = blk >> 3, n = blk & 7;
          p0_transpose_item(A.in[gate ? 8 : 6] + (size_t)n * 128 * 128, 128, 128, (bf16_t*)(ws + WS_WG) + (size_t)(n * 2 + gate) * 128 * 128, 0, 0, scr, sub, lane); }
    }
    bf16_t* XN = (bf16_t*)A.out;
    for (int m = gw; m < MTOT; m += NGW) {
        if (m < MREAL) rms_row_to_bf16(A.in[0] + (size_t)m * DM, A.in[2], XN + (size_t)m * DM, lane);
        else if (m < MREAL + NMETA) rms_row_to_bf16(A.in[1] + (size_t)(m - MREAL) * DM, A.in[2], XN + (size_t)m * DM, lane);
        else { u32x2* o8 = (u32x2*)(XN + (size_t)m * DM) + lane;
#pragma unroll
            for (int j = 0; j < 4; ++j) o8[64 * j] = (u32x2){0u, 0u}; }
    }
    float* cosT = (float*)(ws + WS_COS); float* sinT = (float*)(ws + WS_SIN);
    for (int i = blockIdx.x * 512 + tid; i < NPOS * 32; i += gridDim.x * 512) {
        const int pos = i >> 5, fi = i & 31;
        const float ang = (float)pos * INV_FREQ[fi];
        double rev = (double)ang * 0.15915494309189535; rev -= __builtin_rint(rev);
        const float rf = (float)rev;
        cosT[i] = __builtin_amdgcn_cosf(rf); sinT[i] = __builtin_amdgcn_sinf(rf);
    }
    if (blockIdx.x == 0 && wave == 0) {
        const float a = A.in[11][lane] * A.in[12][lane], b = A.in[13][lane] * A.in[14][lane];
        const float sa = wave_sum(a), sb = wave_sum(b);
        if (lane == 0) ((float*)(ws + WS_CTL))[64] = __expf(sa) - __expf(sb) + 0.2f;
    }
}

__device__ __forceinline__ size_t seqrow(int b, int p) { return p < NMETA ? (size_t)(MREAL + p) : (size_t)b * SEQ + (size_t)(p - NMETA); }
__device__ __forceinline__ void scan_item(int b, int n, const Args& A, LAS unsigned char* lds) {
    const int tid = threadIdx.x, lane = tid & 63, w = __builtin_amdgcn_readfirstlane(tid >> 6), l15 = lane & 15, q4 = lane >> 4;
    constexpr int RP = 272;
    LAS unsigned char* XRt = lds;
    LAS unsigned char* GRt = lds + 18432;
    LAS unsigned char* At = lds + 18432 + 17408;
    LAS float* XCf = (LAS float*)(lds + 18432 + 2 * 17408);
    LAS float* CW = (LAS float*)(lds + 18432 + 2 * 17408 + 33792);
    unsigned char* ws = A.ws;
    const bf16_t* XR = (const bf16_t*)(ws + WS_SEG); const bf16_t* GR = (const bf16_t*)(ws + WS_SEG + SEG_BYTES); bf16_t* YR = (bf16_t*)A.out;
    for (int i = tid; i < 640; i += 512) { const int k = i >> 7, c = i & 127; CW[i] = k < 4 ? A.in[4][k * DM + n * 128 + c] : A.in[5][n * 128 + c]; }
    const int dl = 16 * w + l15, ch = n * 128 + dl;
    bf16x8 bw[2][4];
    { const bf16_t* WG = (const bf16_t*)(ws + WS_WG);
#pragma unroll
      for (int gate = 0; gate < 2; ++gate)
#pragma unroll
          for (int ks = 0; ks < 4; ++ks) bw[gate][ks] = *(const bf16x8*)(WG + ((size_t)(n * 2 + gate) * 128 + dl) * 128 + 32 * ks + 8 * q4); }
    const float ba = A.in[7][ch], bx = A.in[9][ch];
    float sp8;
    { const float e = __expf(-A.in[10][ch]);
      const float sp = (e < 0.05f) ? e * (1.0f + e * (-0.5f + e * (0.33333333f + e * (-0.25f + e * 0.2f)))) : 0.6931471805599453f * __builtin_amdgcn_logf(1.0f + e);
      sp8 = 8.0f * sp; }
    float hprev = 0.f;
    int rr0 = tid >> 4, c16 = tid & 15;
    asm volatile("" : "+v"(rr0), "+v"(c16));
    u32x4 xrg[3], grg[2];
    const u32x4 zero4 = (u32x4){0u, 0u, 0u, 0u};
#define SCAN_LOAD(i_) do { const int p0_ = NMETA + 64 * ((i_) - 1); \
        _Pragma("unroll") for (int j = 0; j < 3; ++j) { const int rr = rr0 + 32 * j; const int p = p0_ - 3 + rr; \
            xrg[j] = (rr < 67 && p >= 0) ? *(const u32x4*)(XR + seqrow(b, p) * DM + n * 128 + c16 * 8) : zero4; } \
        _Pragma("unroll") for (int j = 0; j < 2; ++j) { const int p = p0_ + rr0 + 32 * j; \
            grg[j] = (p >= 0) ? *(const u32x4*)(GR + seqrow(b, p) * DM + n * 128 + c16 * 8) : zero4; } } while (0)
    SCAN_LOAD(0);
    for (int i = 0; i <= 64; ++i) {
#pragma unroll
        for (int j = 0; j < 3; ++j) { const int rr = rr0 + 32 * j; if (rr < 67) *(LAS u32x4*)(XRt + rr * RP + c16 * 16) = xrg[j]; }
#pragma unroll
        for (int j = 0; j < 2; ++j) *(LAS u32x4*)(GRt + (rr0 + 32 * j) * RP + c16 * 16) = grg[j];
        __syncthreads();
        if (i < 64) SCAN_LOAD(i + 1);
#pragma unroll
        for (int j = 0; j < 2; ++j) {
            const int tt = rr0 + 32 * j;
            float a8[8];
            { const f32x4 b0 = *(const LAS f32x4*)(CW + 512 + 8 * c16), b1 = *(const LAS f32x4*)(CW + 512 + 8 * c16 + 4);
              a8[0] = b0[0]; a8[1] = b0[1]; a8[2] = b0[2]; a8[3] = b0[3]; a8[4] = b1[0]; a8[5] = b1[1]; a8[6] = b1[2]; a8[7] = b1[3]; }
#pragma unroll
            for (int k = 0; k < 4; ++k) {
                const u32x4 xv = *(const LAS u32x4*)(XRt + (tt + k) * RP + c16 * 16);
                const f32x4 w0 = *(const LAS f32x4*)(CW + k * 128 + 8 * c16), w1 = *(const LAS f32x4*)(CW + k * 128 + 8 * c16 + 4);
                a8[0] += w0[0] * bflo(xv.x); a8[1] += w0[1] * bfhi(xv.x); a8[2] += w0[2] * bflo(xv.y); a8[3] += w0[3] * bfhi(xv.y);
                a8[4] += w1[0] * bflo(xv.z); a8[5] += w1[1] * bfhi(xv.z); a8[6] += w1[2] * bflo(xv.w); a8[7] += w1[3] * bfhi(xv.w);
            }
            u32x4 pw; pw.x = pk2(a8[0], a8[1]); pw.y = pk2(a8[2], a8[3]); pw.z = pk2(a8[4], a8[5]); pw.w = pk2(a8[6], a8[7]);
            *(LAS u32x4*)(At + tt * RP + c16 * 16) = pw;
            *(LAS f32x4*)(XCf + tt * 132 + 8 * c16) = (f32x4){a8[0], a8[1], a8[2], a8[3]};
            *(LAS f32x4*)(XCf + tt * 132 + 8 * c16 + 4) = (f32x4){a8[4], a8[5], a8[6], a8[7]};
        }
        __syncthreads();
        f32x4 ar[4], ag[4];
#pragma unroll
        for (int mb = 0; mb < 4; ++mb) { ar[mb] = (f32x4){0.f, 0.f, 0.f, 0.f}; ag[mb] = (f32x4){0.f, 0.f, 0.f, 0.f};
#pragma unroll
            for (int ks = 0; ks < 4; ++ks) { const bf16x8 a = *(const LAS bf16x8*)(At + (16 * mb + l15) * RP + (32 * ks + 8 * q4) * 2);
                ar[mb] = __builtin_amdgcn_mfma_f32_16x16x32_bf16(a, bw[0][ks], ar[mb], 0, 0, 0);
                ag[mb] = __builtin_amdgcn_mfma_f32_16x16x32_bf16(a, bw[1][ks], ag[mb], 0, 0, 0); } }
#pragma unroll
        for (int mb = 0; mb < 4; ++mb) {
            float hl[4], cum[4];
#pragma unroll
            for (int j = 0; j < 4; ++j) {
                const int tl = 16 * mb + 4 * q4 + j;
                const float r = fsigmoid(ar[mb][j] + ba), ig = fsigmoid(ag[mb][j] + bx);
                const float la = -sp8 * r;
                float a = __builtin_amdgcn_exp2f(1.4426950408889634f * la);
                const float x2 = 2.0f * la;
                const float om = (x2 > -0.01f) ? -x2 * (1.0f + x2 * (0.5f + x2 * 0.16666667f)) : 1.0f - __builtin_amdgcn_exp2f(1.4426950408889634f * x2);
                float uu = __builtin_amdgcn_sqrtf(om) * ig * XCf[tl * 132 + dl];
                if (i == 0 && tl < 48) { uu = 0.f; a = 1.f; }
                if (j == 0) { hl[0] = uu; cum[0] = a; } else { hl[j] = a * hl[j - 1] + uu; cum[j] = cum[j - 1] * a; }
            }
            float P = cum[3], H = hl[3];
            { const float Pp = __shfl_up(P, 16), Hp = __shfl_up(H, 16); if (q4 >= 1) { H = P * Hp + H; P = P * Pp; } }
            { const float Pp = __shfl_up(P, 32), Hp = __shfl_up(H, 32); if (q4 >= 2) { H = P * Hp + H; P = P * Pp; } }
            const float Pe = __shfl_up(P, 16), He = __shfl_up(H, 16);
            const float hin = (q4 == 0) ? hprev : (Pe * hprev + He);
            const float Pl = __shfl(P, 48 + l15), Hl = __shfl(H, 48 + l15);
            hprev = Pl * hprev + Hl;
#pragma unroll
            for (int j = 0; j < 4; ++j) {
                const int tl = 16 * mb + 4 * q4 + j;
                const float h = hl[j] + cum[j] * hin;
                LAS unsigned short* gp = (LAS unsigned short*)(GRt + tl * RP) + dl;
                const float y = __uint_as_float(((unsigned)*gp) << 16) * h;
                *gp = (unsigned short)f2bf(y);
            }
        }
        __syncthreads();
        if (i >= 1) {
#pragma unroll
            for (int j = 0; j < 2; ++j) { const int rr = rr0 + 32 * j; const u32x4 v = *(const LAS u32x4*)(GRt + rr * RP + c16 * 16);
                *(u32x4*)(YR + ((size_t)b * SEQ + 64 * (i - 1) + rr) * (2 * DM) + n * 128 + c16 * 8) = v; }
        }
        __syncthreads();
    }
#undef SCAN_LOAD
}

__device__ __forceinline__ int crow(int r, int hi) { return (r & 3) + 8 * (r >> 2) + 4 * hi; }
constexpr int KP = 272, VP = 320, KB_BYTES = 64 * KP, VB_BYTES = 64 * VP, ABUF = KB_BYTES + VB_BYTES;
struct AttnSt {
    f32x16 o[4]; f32x16 negm; u32x4 pw[4]; float m, l; u32x4 kr[2], vr[2];
};
template <bool GEN> __device__ __forceinline__ void attn_step(AttnSt& st, const int t, const int NT, const int qb, LAS unsigned char* lds, const bf16x8 (&qf)[4],
                                                              const bf16_t* Kg, const bf16_t* Vg, const size_t brow, const int srow0, const int sc16,
                                                              const int koff, const int voff, const int qrel, const int hi) {
    const bool has_next = GEN ? (t + 1 < NT) : true, has_prev = GEN ? (t >= 1) : true;
    if (has_next) { const size_t rb = brow + 64 * t;
#pragma unroll
        for (int jj = 0; jj < 2; ++jj) st.kr[jj] = *(const u32x4*)(Kg + (rb + srow0 + 32 * jj) * DM); }
    { const size_t rb = (GEN && t == 0) ? (size_t)MREAL : brow + 64 * (t - 1);
#pragma unroll
        for (int jj = 0; jj < 2; ++jj) st.vr[jj] = *(const u32x4*)(Vg + (rb + srow0 + 32 * jj) * DM); }
#define VREAD(buf_, g_) do { _Pragma("unroll") for (int e = 0; e < 2; ++e) { \
        vlo[buf_][e] = __builtin_amdgcn_ds_read_tr16_b64_v4i16((LAS v4i16_t*)(vb + (16 * ((g_) >> 1)) * VP + (2 * ((g_) & 1) + e) * 64)); \
        vhi[buf_][e] = __builtin_amdgcn_ds_read_tr16_b64_v4i16((LAS v4i16_t*)(vb + (16 * ((g_) >> 1) + 8) * VP + (2 * ((g_) & 1) + e) * 64)); } } while (0)
    LAS unsigned char* vb = lds + 2 * KB_BYTES + ((t - 1) & 1) * VB_BYTES + voff;
    v4i16_t vlo[2][2], vhi[2][2];
    f32x16 n0, n1;
    {
        LAS unsigned char* Kb = lds + (t & 1) * KB_BYTES + koff;
#pragma unroll
        for (int ks = 0; ks < 4; ++ks) {
            const bf16x8 a0 = *(const LAS bf16x8*)(Kb + 32 * ks), a1 = *(const LAS bf16x8*)(Kb + 32 * KP + 32 * ks);
            if (ks == 0) { n0 = __builtin_amdgcn_mfma_f32_32x32x16_bf16(a0, qf[ks], st.negm, 0, 0, 0); n1 = __builtin_amdgcn_mfma_f32_32x32x16_bf16(a1, qf[ks], st.negm, 0, 0, 0); }
            else { n0 = __builtin_amdgcn_mfma_f32_32x32x16_bf16(a0, qf[ks], n0, 0, 0, 0); n1 = __builtin_amdgcn_mfma_f32_32x32x16_bf16(a1, qf[ks], n1, 0, 0, 0); }
        }
    }
    if (has_prev) VREAD(0, 0);
    if (GEN) {
        if (t == 0) {
#pragma unroll
            for (int r = 0; r < 16; ++r) { if (r >= 8) n0[r] = -INFINITY; n1[r] = -INFINITY; }
        } else if (t - 1 >= 2 * qb) {
            const int kb0 = 64 * (t - 1 - 2 * qb);
#pragma unroll
            for (int r = 0; r < 16; ++r) { const int kk = kb0 + crow(r, hi); if (kk > qrel) n0[r] = -INFINITY; if (kk + 32 > qrel) n1[r] = -INFINITY; }
        }
    }
    float rm;
    { float a = fmaxf(fmaxf(n0[0], n0[1]), n1[0]), b = fmaxf(fmaxf(n0[2], n0[3]), n1[1]); a = fmaxf(fmaxf(a, n1[2]), n1[3]);
#pragma unroll
      for (int r = 4; r < 16; r += 4) { a = fmaxf(fmaxf(a, n0[r]), n0[r + 1]); b = fmaxf(fmaxf(b, n0[r + 2]), n0[r + 3]); a = fmaxf(fmaxf(a, n1[r]), n1[r + 1]); b = fmaxf(fmaxf(b, n1[r + 2]), n1[r + 3]); }
      rm = fmaxf(a, b); }
    { const auto rr = __builtin_amdgcn_permlane32_swap(__float_as_uint(rm), __float_as_uint(rm), false, false); rm = fmaxf(__uint_as_float(rr[0]), __uint_as_float(rr[1])); }
    const bool grow = (GEN && t == 0) ? true : (rm > 8.0f);
    const bool any_grow = __any(grow);
    float alpha = 1.0f;
    if (any_grow) {
        const float dl = grow ? rm : 0.f;
        alpha = (GEN && t == 0) ? 0.f : __builtin_amdgcn_exp2f(-dl);
        st.m += dl;
#pragma unroll
        for (int r = 0; r < 16; ++r) { n0[r] -= dl; n1[r] -= dl; st.negm[r] = -st.m; }
    }
    float sa = 0.f, sb = 0.f;
    u32x4 npw[4];
#pragma unroll
    for (int g8 = 0; g8 < 8; ++g8) {
        if (has_prev && g8 < 7) VREAD((g8 + 1) & 1, g8 + 1);
        __builtin_amdgcn_sched_barrier(0);
        if (has_prev) {
            const bf16x8 pf = __builtin_bit_cast(bf16x8, st.pw[g8 >> 1]);
#pragma unroll
            for (int e = 0; e < 2; ++e) {
                const v4i16_t lo = vlo[g8 & 1][e], hh = vhi[g8 & 1][e];
                const bf16x8 vf = (bf16x8){lo[0], lo[1], lo[2], lo[3], hh[0], hh[1], hh[2], hh[3]};
                st.o[2 * (g8 & 1) + e] = __builtin_amdgcn_mfma_f32_32x32x16_bf16(vf, pf, st.o[2 * (g8 & 1) + e], 0, 0, 0);
            }
        }
        {
            const int r = 2 * g8;
            const float x0 = __builtin_amdgcn_exp2f(n0[r]), x1 = __builtin_amdgcn_exp2f(n0[r + 1]);
            const float y0 = __builtin_amdgcn_exp2f(n1[r]), y1 = __builtin_amdgcn_exp2f(n1[r + 1]);
            sa += x0 + y0; sb += x1 + y1;
            npw[g8 >> 2][g8 & 3] = pk2(x0, x1); npw[2 + (g8 >> 2)][g8 & 3] = pk2(y0, y1);
        }
        __builtin_amdgcn_sched_barrier(0);
    }
#undef VREAD
    st.l = st.l * alpha + (sa + sb);
    if (any_grow) {
#pragma unroll
        for (int e = 0; e < 4; ++e)
#pragma unroll
            for (int r = 0; r < 16; ++r) st.o[e][r] *= alpha;
    }
#pragma unroll
    for (int k = 0; k < 4; ++k) st.pw[k] = npw[k];
    if (has_next) {
#pragma unroll
        for (int jj = 0; jj < 2; ++jj) *(LAS u32x4*)(lds + ((t + 1) & 1) * KB_BYTES + (srow0 + 32 * jj) * KP + sc16 * 16) = st.kr[jj]; }
#pragma unroll
    for (int jj = 0; jj < 2; ++jj) *(LAS u32x4*)(lds + 2 * KB_BYTES + (t & 1) * VB_BYTES + (srow0 + 32 * jj) * VP + sc16 * 16) = st.vr[jj];
    __syncthreads();
}
__device__ __forceinline__ void attn_unit(int b, int h, int qb, const Args& A, float lam, LAS unsigned char* lds) {
    const int tid = threadIdx.x, lane = tid & 63, wid = __builtin_amdgcn_readfirstlane(tid >> 6), c = wid & 1, g = wid >> 1, r32 = lane & 31, hi = lane >> 5;
    unsigned char* ws = A.ws;
    const bf16_t* Q = (const bf16_t*)(ws + WS_SEG + 2 * SEG_BYTES); const bf16_t* K = (const bf16_t*)(ws + WS_SEG + 3 * SEG_BYTES); const bf16_t* V = (const bf16_t*)(ws + WS_SEG + 4 * SEG_BYTES);
    const size_t rowq = (size_t)b * SEQ + qb * 128 + 32 * g + r32;
    bf16x8 qf[4];
#pragma unroll
    for (int ks = 0; ks < 4; ++ks) qf[ks] = *(const bf16x8*)(Q + rowq * DM + h * 128 + c * 64 + 16 * ks + 8 * hi);
    AttnSt st;
#pragma unroll
    for (int e = 0; e < 4; ++e)
#pragma unroll
        for (int r = 0; r < 16; ++r) st.o[e][r] = 0.f;
    st.m = 0.f; st.l = 0.f;
#pragma unroll
    for (int r = 0; r < 16; ++r) st.negm[r] = 0.f;
#pragma unroll
    for (int k = 0; k < 4; ++k) st.pw[k] = (u32x4){0u, 0u, 0u, 0u};
    const int NT = 2 * qb + 3;
    int srow0 = tid >> 4, sc16 = tid & 15;
    asm volatile("" : "+v"(srow0), "+v"(sc16));
    const bf16_t* Kg = K + h * 128 + sc16 * 8; const bf16_t* Vg = V + h * 128 + sc16 * 8;
    const size_t brow = (size_t)b * SEQ;
    const int koff = r32 * KP + 128 * c + 16 * hi;
    const int voff = (4 * hi + ((lane & 15) >> 2)) * VP + (16 * ((lane >> 4) & 1) + 4 * (lane & 3)) * 2;
    const int qrel = 32 * g + r32;
    {
#pragma unroll
        for (int jj = 0; jj < 2; ++jj) { const u32x4 k0 = *(const u32x4*)(Kg + ((size_t)MREAL + srow0 + 32 * jj) * DM); *(LAS u32x4*)(lds + (srow0 + 32 * jj) * KP + sc16 * 16) = k0; }
        __syncthreads();
    }
    int t = 0;
    attn_step<true>(st, 0, NT, qb, lds, qf, Kg, Vg, brow, srow0, sc16, koff, voff, qrel, hi);
    for (t = 1; t + 2 < NT; ++t) attn_step<false>(st, t, NT, qb, lds, qf, Kg, Vg, brow, srow0, sc16, koff, voff, qrel, hi);
    for (; t < NT; ++t) attn_step<true>(st, t, NT, qb, lds, qf, Kg, Vg, brow, srow0, sc16, koff, voff, qrel, hi);
    {
        LAS unsigned char* vb = lds + 2 * KB_BYTES + ((NT - 1) & 1) * VB_BYTES + voff;
#pragma unroll
        for (int s = 0; s < 4; ++s) {
            const bf16x8 pf = __builtin_bit_cast(bf16x8, st.pw[s]);
#pragma unroll
            for (int e = 0; e < 4; ++e) {
                const v4i16_t lo = __builtin_amdgcn_ds_read_tr16_b64_v4i16((LAS v4i16_t*)(vb + (16 * s) * VP + e * 64));
                const v4i16_t hh = __builtin_amdgcn_ds_read_tr16_b64_v4i16((LAS v4i16_t*)(vb + (16 * s + 8) * VP + e * 64));
                const bf16x8 vf = (bf16x8){lo[0], lo[1], lo[2], lo[3], hh[0], hh[1], hh[2], hh[3]};
                st.o[e] = __builtin_amdgcn_mfma_f32_32x32x16_bf16(vf, pf, st.o[e], 0, 0, 0);
            }
        }
    }
    __syncthreads();
    float l = st.l; l += __shfl_xor(l, 32);
    const float inv = 1.0f / l;
    LAS float* comb = (LAS float*)lds + g * 4096;
    if (c == 1) {
        const float sc = lam * inv;
#pragma unroll
        for (int e = 0; e < 4; ++e)
#pragma unroll
            for (int r = 0; r < 16; ++r) comb[(e * 16 + r) * 64 + lane] = st.o[e][r] * sc;
    }
    __syncthreads();
    if (c == 0) {
        float ss = 0.f;
#pragma unroll
        for (int e = 0; e < 4; ++e)
#pragma unroll
            for (int r = 0; r < 16; ++r) { const float d = st.o[e][r] * inv - comb[(e * 16 + r) * 64 + lane]; st.o[e][r] = d; ss += d * d; }
        ss += __shfl_xor(ss, 32);
        const float rms = __builtin_amdgcn_rsqf(ss * (1.0f / 128.0f) + EPS) * 0.8f;
        const float* gs = A.in[15];
        bf16_t* orow = (bf16_t*)A.out + rowq * (2 * DM) + DM + h * 128;
#pragma unroll
        for (int e = 0; e < 4; ++e)
#pragma unroll
            for (int rr = 0; rr < 4; ++rr) {
                const int e0 = 32 * e + 8 * rr + 4 * hi;
                const f32x4 gv = *(const f32x4*)(gs + e0);
                u32x2 w; w.x = pk2(st.o[e][4 * rr] * rms * gv[0], st.o[e][4 * rr + 1] * rms * gv[1]); w.y = pk2(st.o[e][4 * rr + 2] * rms * gv[2], st.o[e][4 * rr + 3] * rms * gv[3]);
                *(u32x2*)(orow + e0) = w;
            }
    }
    __syncthreads();
}

#define RLX_AGENT __ATOMIC_RELAXED, __HIP_MEMORY_SCOPE_AGENT
#define XB_TMO      128
#define XB_XCNT(j)  (256  + 64 * (j))
#define XB_XSUB(j)  (1280 + 64 * (j))
#define XB_XGEN(j)  (2304 + 64 * (j))
#define XB_TOP      3328
#define XB_TOPGEN   3392
#define XCD_BAR_WORDS 3456
#define XB_SPIN_CAP (1u << 18)

__device__ __forceinline__ unsigned xb_ld(unsigned* p)              { return __hip_atomic_load(p, __ATOMIC_RELAXED, __HIP_MEMORY_SCOPE_AGENT); }
__device__ __forceinline__ unsigned xb_add(unsigned* p, unsigned v) { return __hip_atomic_fetch_add(p, v, __ATOMIC_RELAXED, __HIP_MEMORY_SCOPE_AGENT); }
__device__ __forceinline__ unsigned xb_xcc_id() { return (unsigned)__builtin_amdgcn_s_getreg((3 << 11) | 20) & 0xFu; }
#define XB_SPIN(cond, bar) do { unsigned _sp = 0; while (cond) { __builtin_amdgcn_s_sleep(1); \
    if ((++_sp & 255u) == 0u) { if (xb_ld(&(bar)[XB_TMO])) break; if (_sp > XB_SPIN_CAP) { atomicAdd(&(bar)[XB_TMO], 1u); break; } } } } while (0)

struct XcdBarrier {
    unsigned* bar; unsigned x;
    volatile LAS unsigned* st;
};

__device__ __forceinline__ XcdBarrier xcd_barrier_post(unsigned* bar, volatile LAS unsigned* st) {
    XcdBarrier b; b.bar = bar; b.x = xb_xcc_id(); b.st = st;
    if (threadIdx.x == 0) (void)xb_add(&bar[XB_XCNT(b.x)], 1u);
    return b;
}
__device__ __forceinline__ void xcd_barrier_complete(unsigned* bar, unsigned x, unsigned& nloc, unsigned& nx) {
    const unsigned G = gridDim.x * gridDim.y * gridDim.z;
    unsigned sum, cnt, mine, sp = 0u;
    for (;;) {
        sum = 0u; cnt = 0u; mine = 0u;
#pragma unroll
        for (unsigned j = 0; j < 16; ++j) { const unsigned c = xb_ld(&bar[XB_XCNT(j)]); sum += c; cnt += (c > 0u) ? 1u : 0u; mine = (j == x) ? c : mine; }
        if (sum == G) break;
        __builtin_amdgcn_s_sleep(1);
        if ((++sp & 255u) == 0u) { if (xb_ld(&bar[XB_TMO])) break; if (sp > XB_SPIN_CAP) { atomicAdd(&bar[XB_TMO], 1u); break; } }
    }
    nloc = mine > 0u ? mine : 1u; nx = cnt > 0u ? cnt : 1u;
}

__device__ __forceinline__ void xcd_barrier(const XcdBarrier& b) {
    asm volatile("s_waitcnt vmcnt(0)" ::: "memory");
    __syncthreads();
    if (threadIdx.x == 0) {
        unsigned* bar = b.bar;
        __builtin_amdgcn_s_waitcnt(0);
        unsigned nloc = b.st[0], nx = b.st[1];
        if (nloc == 0u) { xcd_barrier_complete(bar, b.x, nloc, nx); b.st[0] = nloc; b.st[1] = nx; }
        const unsigned old = xb_add(&bar[XB_XSUB(b.x)], 1u);
        const unsigned gen = old / nloc;
        if (old + 1u == (gen + 1u) * nloc) {
            __builtin_amdgcn_fence(__ATOMIC_RELEASE, "agent");
            asm volatile("s_waitcnt vmcnt(0)" ::: "memory");
            const unsigned og = xb_add(&bar[XB_TOP], 1u);
            const unsigned tg = og / nx;
            if (og + 1u == (tg + 1u) * nx) xb_add(&bar[XB_TOPGEN], 1u);
            else XB_SPIN(xb_ld(&bar[XB_TOPGEN]) == tg, bar);
            __builtin_amdgcn_fence(__ATOMIC_ACQUIRE, "agent");
            xb_add(&bar[XB_XGEN(b.x)], 1u);
            asm volatile("s_waitcnt vmcnt(0)" ::: "memory");
        } else {
            XB_SPIN(xb_ld(&bar[XB_XGEN(b.x)]) == gen, bar);
            __builtin_amdgcn_fence(__ATOMIC_ACQUIRE, "agent");
            asm volatile("s_waitcnt vmcnt(0)" ::: "memory");
        }
    }
    __syncthreads();
}


__global__ void __launch_bounds__(512, 2) fwd_megakernel(Args A) {
    extern __shared__ __attribute__((aligned(16))) unsigned char lds_raw[];
    LAS unsigned char* lds = (LAS unsigned char*)lds_raw;
    cg::grid_group grid = cg::this_grid();
    { volatile LAS unsigned* m0 = (volatile LAS unsigned*)(lds + MISC_OFF); if (threadIdx.x < 16) m0[threadIdx.x] = 0u; }
    __syncthreads();
    const XcdBarrier xbar = xcd_barrier_post((unsigned*)(A.ws + WS_CTL) + 4096 + 4096 * A.pad, (volatile LAS unsigned*)(lds + MISC_OFF) + 8);
    const int tid = threadIdx.x, lane = tid & 63, wave = __builtin_amdgcn_readfirstlane(tid >> 6);
    const int G = gridDim.x;
    unsigned char* ws = A.ws;
    bf16_t* SEG0 = (bf16_t*)(ws + WS_SEG);
    float* PART1 = (float*)(ws + WS_PART1); float* PART2 = (float*)(ws + WS_PART2);

    if (A.mask & 1) { p0_prologue(A, lds, tid, lane, wave);
    xcd_barrier(xbar); }
    if (A.mask < 0) grid.sync();

    if (A.mask & 2) { pg8::Gemm g{(const bf16_t*)A.out, (const bf16_t*)(ws + WS_WIN), MTOT, INCOLS, DM}; pg8::StaticOrder S; S.init(MTOT, INCOLS, G, (int)blockIdx.x);
      EpiProj E{SEG0, (const float*)(ws + WS_COS), (const float*)(ws + WS_SIN)};
      pg8::gemm_phase<EpiProj, pg8::StaticOrder, true, true>(lds, g, S, E);
    xcd_barrier(xbar); }

    if (A.mask & 4) {
        const float lam = ((const float*)(ws + WS_CTL))[64];
        const unsigned xcd = ((unsigned)__builtin_amdgcn_s_getreg((3 << 11) | 20) & 0xFu) & 7u;
        volatile LAS int* misc = (volatile LAS int*)(lds + MISC_OFF);
        constexpr int NSCAN_X = NB * 8 / 8, NATT_X = NB * 8 * 32 / 8;
        for (;;) {
            if (tid == 0) {
                int q = misc[1], v = -1;
                while (q < 8) {
                    const int xq = (int)((xcd + (unsigned)q) & 7u);
                    const int it = (int)atomicAdd((unsigned*)(ws + WS_CTL) + 128 + 64 * xq + 1024 * A.pad, 1u);
                    if (it < NSCAN_X + NATT_X) { v = (xq << 16) | it; break; }
                    ++q;
                }
                misc[1] = q; misc[0] = v;
            }
            __syncthreads();
            const int v = misc[0];
            __syncthreads();
            if (v < 0) break;
            const int xq = v >> 16, it = v & 0xffff;
            if (it < NSCAN_X) { const int si = xq * NSCAN_X + it; scan_item(si >> 3, si & 7, A, lds); }
            else { const int a = it - NSCAN_X; const int qb = 31 - (a & 31), bh = xq * 16 + (a >> 5); attn_unit(bh >> 3, bh & 7, qb, A, lam, lds); }
        }
    xcd_barrier(xbar); }

    if (A.mask & 8) {
    { pg8::Gemm g{(const bf16_t*)A.out, (const bf16_t*)(ws + WS_WRNN), MREAL, DM, 2 * DM}; pg8::StaticOrder S; S.init(MREAL, DM, G, (int)blockIdx.x);
      EpiMerge E{SEG0, SEG0 + 5 * SEG_ELEMS, SEG0 + 6 * SEG_ELEMS};
      pg8::gemm_phase<EpiMerge, pg8::StaticOrder, true, true>(lds, g, S, E); }
    xcd_barrier(xbar); }

    if (A.mask & 16) { pg8::Gemm g{SEG0, (const bf16_t*)(ws + WS_WO), MREAL, DM, DM}; pg8::StaticOrder S; S.init(MREAL, DM, G, (int)blockIdx.x);
      EpiRes<true> E{A.in[0], nullptr, SEG0 + 6 * SEG_ELEMS, SEG0 + 1 * SEG_ELEMS, A.in[19], PART1};
      pg8::gemm_phase<EpiRes<true>, pg8::StaticOrder, true, true>(lds, g, S, E);
    xcd_barrier(xbar); }

    if (A.mask & 32) { pg8::Gemm g{SEG0 + 1 * SEG_ELEMS, (const bf16_t*)(ws + WS_W1), MREAL, DFF, DM}; pg8::StaticOrder S; S.init(MREAL, DFF, G, (int)blockIdx.x);
      EpiFF1 E{SEG0 + 2 * SEG_ELEMS, PART1};
      pg8::gemm_phase<EpiFF1, pg8::StaticOrder, true, true>(lds, g, S, E);
    xcd_barrier(xbar); }

    if (A.mask & 64) { pg8::Gemm g{SEG0 + 2 * SEG_ELEMS, (const bf16_t*)(ws + WS_W2), MREAL, DM, DFF}; pg8::StaticOrder S; S.init(MREAL, DM, G, (int)blockIdx.x);
      EpiRes<false> E{nullptr, SEG0 + 6 * SEG_ELEMS, SEG0, nullptr, nullptr, PART2};
      pg8::gemm_phase<EpiRes<false>, pg8::StaticOrder, true, true>(lds, g, S, E);
    xcd_barrier(xbar);

    {
        const int gw = blockIdx.x * 8 + wave, NGW = G * 8;
        const f32x4* gf = (const f32x4*)A.in[22] + lane;
        f32x4 gv[4];
#pragma unroll
        for (int j = 0; j < 4; ++j) gv[j] = gf[64 * j];
        for (int mrow = gw; mrow < MREAL; mrow += NGW) {
            const float pv = (lane < 16) ? PART2[(size_t)mrow * 16 + lane] : 0.f;
            const float rstd = 1.0f / sqrtf(wave_sum(pv) * (1.0f / DM) + EPS);
            f32x4* orow = (f32x4*)(A.out + (size_t)mrow * DM) + lane; const u32x2* hrow = (const u32x2*)(SEG0 + (size_t)mrow * DM) + lane;
#pragma unroll
            for (int j = 0; j < 4; ++j) { const u32x2 p = __builtin_nontemporal_load(hrow + 64 * j); const f32x4 v = (f32x4){bflo(p.x), bfhi(p.x), bflo(p.y), bfhi(p.y)}; __builtin_nontemporal_store(v * rstd * gv[j], orow + 64 * j); }
        }
    }
    }
}

#ifndef PHM_A
#define PHM_A 127
#endif
extern "C" void kernel_launch(void* const* d_in, const int* in_sizes, int n_in, void* d_out, int out_size, void* d_ws, size_t ws_size, hipStream_t stream) {
    static int grid = 0;
    if (grid == 0) {
        if (n_in != 23 || out_size != MREAL * DM || ws_size < WS_END) { fprintf(stderr, "kernel_launch: unexpected shapes: n_in %d out %d ws %zu (need %zu)\n", n_in, out_size, ws_size, (size_t)WS_END); grid = -1; return; }
        int dev = 0, cus = 0, per_cu = 0;
        hipGetDevice(&dev); hipDeviceGetAttribute(&cus, hipDeviceAttributeMultiprocessorCount, dev);
        hipFuncSetAttribute((const void*)fwd_megakernel, hipFuncAttributeMaxDynamicSharedMemorySize, LDS_BYTES);
        hipOccupancyMaxActiveBlocksPerMultiprocessor(&per_cu, (const void*)fwd_megakernel, 512, LDS_BYTES);
        if (per_cu < 1) per_cu = 1;
        (void)hipGetLastError();
        grid = cus * per_cu;
    }
    if (grid < 0) return;
    hipMemsetAsync((char*)d_ws + WS_CTL, 0, 65536, stream);
    Args a{};
    for (int i = 0; i < 23; ++i) a.in[i] = (const float*)d_in[i];
    a.out = (float*)d_out; a.ws = (unsigned char*)d_ws; a.mask = PHM_A; a.pad = 0;
    void* args[] = {&a};
    hipError_t e = hipLaunchCooperativeKernel((const void*)fwd_megakernel, dim3(grid), dim3(512), args, LDS_BYTES, stream);
#ifdef PHM_B
    a.mask = PHM_B; a.pad = 1;
    e = hipLaunchCooperativeKernel((const void*)fwd_megakernel, dim3(grid), dim3(512), args, LDS_BYTES, stream);
#endif
    if (e != hipSuccess) fprintf(stderr, "cooperative launch failed: %s (grid %d)\n", hipGetErrorString(e), grid);
}
```

```cpp
#include <hip/hip_runtime.h>
#include <hip/hip_cooperative_groups.h>
#include <cstdio>
#include <cstdint>
#include <cmath>
namespace cg = cooperative_groups;
namespace pg8 {
#define PG8_LAS __attribute__((address_space(3)))
typedef unsigned short bf16_t;
typedef short bf16x8 __attribute__((ext_vector_type(8)));
typedef float f32x4 __attribute__((ext_vector_type(4)));
typedef unsigned u32x4 __attribute__((ext_vector_type(4)));
constexpr int BM = 256, BK = 64, HALF = 128, HTB = HALF * BK * 2  , STAGE_BYTES = 8 * HTB, NXCD = 8, WGM = 8;

__host__ __device__ __forceinline__ int lds_byte(int r, int c) { const int st = (r >> 4) * 2 + (c >> 5), rr = r & 15, cc = c & 31, ob = rr * 64 + cc * 2; return st * 1024 + (ob ^ (((ob >> 9) & 1) << 5)); }
__host__ __device__ __forceinline__ void stage_rc(int b, int& R, int& C) { const int st = b / 1024, sb = b % 1024, swz = sb ^ (((sb >> 9) & 1) << 5); R = (st >> 1) * 16 + swz / 64; C = (st & 1) * 32 + (swz % 64) / 2; }
__host__ __device__ __forceinline__ int perm32(int rho) { const int n = rho >> 4, i = rho & 15; return 8 * (i >> 2) + 4 * n + (i & 3); }

struct Unit { int pm, pn; };
struct Gemm { const bf16_t* A; const bf16_t* Bt; int M, N, K; };

struct StaticOrder {
    int nM, nN, nwg, G, c;
    __host__ __device__ void init(int M, int N, int G_, int c_) { nM = M / BM; nN = N / BM; nwg = nM * nN; G = G_; c = c_; }
    __host__ __device__ bool next(int i, Unit& u) const {
        const long L = (long)i * G + c; if (L >= nwg) return false;
        int wgid = (int)L; { const int q = nwg / NXCD, r = nwg % NXCD, xcd = wgid % NXCD, off = wgid / NXCD; wgid = (xcd < r ? xcd * (q + 1) : r * (q + 1) + (xcd - r) * q) + off; }
        const int nig = WGM * nN, gid = wgid / nig, fm = gid * WGM, gsz = (nM - fm) < WGM ? (nM - fm) : WGM;
        u.pm = fm + ((wgid % nig) % gsz); u.pn = (wgid % nig) / gsz; return true;
    }
    __device__ __forceinline__ void a_ready(const Unit&) const {}
    __device__ __forceinline__ void done(const Unit&) const {}
};

__device__ __forceinline__ unsigned cvt_pk_bf16(float lo, float hi) { unsigned r; asm volatile("v_cvt_pk_bf16_f32 %0, %1, %2" : "=v"(r) : "v"(lo), "v"(hi)); return r; }
template <class Epi, class Sched, bool ALIGN_EPI = false, bool SP2 = false>
__device__ __forceinline__ void gemm_phase(PG8_LAS unsigned char* lds, const Gemm g, const Sched& S, const Epi& E) {
    const int tid = threadIdx.x, wid = __builtin_amdgcn_readfirstlane(tid >> 6), lane = tid & 63, wr = wid >> 2, wc = wid & 3, fr = lane & 15, fq = lane >> 4;
    const int K = g.K, nt = K / BK;
    unsigned voffA[2], voffB[2];
#pragma unroll
    for (int i = 0; i < 2; ++i) { int R, C; stage_rc(tid * 16 + i * 8192, R, C); const int Rb = Epi::PERM ? ((R & ~31) + perm32(R & 31)) : R;
        voffA[i] = (unsigned)(R * K + C) * 2u; voffB[i] = (unsigned)(Rb * K + C) * 2u; }
    const size_t kstep = (size_t)(BK * 2);
    const size_t hstep = (size_t)HALF * K * 2;
    const size_t tstep = 2 * hstep;
    const unsigned ldsw = (unsigned)wid * 1024u;
    const int aoff = lds_byte(wr * 64 + fr, fq * 8), boff = lds_byte(wc * 32 + fr, fq * 8);
#define PG8_SA(b, h) (((b) * 2 + (h)) * HTB)
#define PG8_SB(b, h) ((4 + (b) * 2 + (h)) * HTB)
#define PG8_STAGE(bufoff, gbase, voff) do { _Pragma("unroll") for (int _i = 0; _i < 2; ++_i) \
        __builtin_amdgcn_global_load_lds((const unsigned*)((const char*)(gbase) + (voff)[_i]), (PG8_LAS unsigned*)(lds + (bufoff) + ldsw + _i * 8192), 16, 0, 0); } while (0)
#define PG8_LDA(dst, b, h) do { _Pragma("unroll") for (int m = 0; m < 4; ++m) _Pragma("unroll") for (int k = 0; k < 2; ++k) dst[m][k] = *(const PG8_LAS bf16x8*)(lds + PG8_SA(b, h) + aoff + m * 2048 + k * 1024); } while (0)
#define PG8_LDB(dst, b, h) do { _Pragma("unroll") for (int n = 0; n < 2; ++n) _Pragma("unroll") for (int k = 0; k < 2; ++k) dst[n][k] = *(const PG8_LAS bf16x8*)(lds + PG8_SB(b, h) + boff + n * 2048 + k * 1024); } while (0)
#define PG8_MMA(ai, bj, At, Bt) do { __builtin_amdgcn_s_setprio(1); _Pragma("unroll") for (int m = 0; m < 4; ++m) _Pragma("unroll") for (int n = 0; n < 2; ++n) _Pragma("unroll") for (int k = 0; k < 2; ++k) \
        acc[ai][bj][m][n] = __builtin_amdgcn_mfma_f32_16x16x32_bf16(Bt[n][k], At[m][k], acc[ai][bj][m][n], 0, 0, 0); __builtin_amdgcn_s_setprio(0); } while (0)
#define PG8_WAIT_V(n) asm volatile("s_waitcnt vmcnt(" #n ")" ::: "memory")
#define PG8_WAIT_L(n) asm volatile("s_waitcnt lgkmcnt(" #n ")" ::: "memory")
#define PG8_BAR __builtin_amdgcn_s_barrier()
#define PG8_SCHED __builtin_amdgcn_sched_barrier(0)
    Unit cur, nxt; int ui = 0;
    if (!S.next(0, cur)) return;
    f32x4 acc[2][2][4][2];
#pragma unroll
    for (int a = 0; a < 2; ++a)
#pragma unroll
        for (int b = 0; b < 2; ++b)
#pragma unroll
            for (int m = 0; m < 4; ++m)
#pragma unroll
                for (int n = 0; n < 2; ++n) acc[a][b][m][n] = (f32x4){0.f, 0.f, 0.f, 0.f};
    bf16x8 At[4][2], B0[2][2], B1[2][2];
    const char* cA = (const char*)g.A + (size_t)cur.pm * tstep; const char* cB = (const char*)g.Bt + (size_t)cur.pn * tstep;
    S.a_ready(cur);
    if constexpr (SP2) {
        PG8_STAGE(PG8_SB(0, 0), cB, voffB); PG8_STAGE(PG8_SB(0, 1), cB + hstep, voffB); PG8_STAGE(PG8_SA(0, 0), cA, voffA); PG8_STAGE(PG8_SA(0, 1), cA + hstep, voffA);
        if (wr == 1) PG8_BAR;
        PG8_WAIT_V(2); PG8_BAR;
        PG8_STAGE(PG8_SB(1, 0), cB + kstep, voffB); PG8_STAGE(PG8_SA(1, 0), cA + kstep, voffA); PG8_STAGE(PG8_SB(1, 1), cB + hstep + kstep, voffB);
        PG8_WAIT_V(6); PG8_BAR;
    } else {
        PG8_STAGE(PG8_SB(0, 0), cB, voffB); PG8_STAGE(PG8_SA(0, 0), cA, voffA); PG8_STAGE(PG8_SB(0, 1), cB + hstep, voffB); PG8_STAGE(PG8_SA(0, 1), cA + hstep, voffA);
        if (wr == 1) PG8_BAR;
        PG8_WAIT_V(4); PG8_BAR;
        PG8_STAGE(PG8_SB(1, 0), cB + kstep, voffB); PG8_STAGE(PG8_SA(1, 0), cA + kstep, voffA); PG8_STAGE(PG8_SB(1, 1), cB + hstep + kstep, voffB);
        PG8_WAIT_V(6); PG8_BAR;
    }
    for (;;) {
        const bool has_next = S.next(ui + 1, nxt);
        const char* nA = has_next ? (const char*)g.A + (size_t)nxt.pm * tstep : cA; const char* nB = has_next ? (const char*)g.Bt + (size_t)nxt.pn * tstep : cB;
        for (int t = 0; t < nt; t += 2) {
            if constexpr (Epi::HAS_MID) { if (t == (nt >> 1)) E.mid(acc, cur, wr, wc, fr, fq); }
            const bool last = (t == nt - 2);
            const char* a1 = cA + (size_t)(t + 1) * kstep;
            const char* a2 = last ? nA : cA + (size_t)(t + 2) * kstep; const char* b2 = last ? nB : cB + (size_t)(t + 2) * kstep;
            const char* a3 = a2 + kstep; const char* b3 = b2 + kstep;
            if (last && has_next) S.a_ready(nxt);
            if constexpr (SP2) {
            PG8_LDB(B0, 0, 0); PG8_LDB(B1, 0, 1); PG8_SCHED; PG8_LDA(At, 0, 0); PG8_STAGE(PG8_SA(1, 1), a1 + hstep, voffA);
            PG8_WAIT_V(8); PG8_WAIT_L(0); PG8_BAR; PG8_MMA(0, 0, At, B0); PG8_MMA(0, 1, At, B1); PG8_BAR; PG8_SCHED;
            PG8_LDA(At, 0, 1); PG8_STAGE(PG8_SB(0, 0), b2, voffB); PG8_STAGE(PG8_SB(0, 1), b2 + hstep, voffB); PG8_STAGE(PG8_SA(0, 0), a2, voffA);
            PG8_WAIT_V(8); PG8_WAIT_L(0); PG8_BAR; PG8_MMA(1, 0, At, B0); PG8_MMA(1, 1, At, B1); PG8_BAR; PG8_SCHED;
            PG8_LDB(B0, 1, 0); PG8_LDB(B1, 1, 1); PG8_SCHED; PG8_LDA(At, 1, 0); PG8_STAGE(PG8_SA(0, 1), a2 + hstep, voffA);
            PG8_WAIT_V(8); PG8_WAIT_L(0); PG8_BAR; PG8_MMA(0, 0, At, B0); PG8_MMA(0, 1, At, B1); PG8_BAR; PG8_SCHED;
            PG8_LDA(At, 1, 1); PG8_STAGE(PG8_SB(1, 0), b3, voffB); PG8_STAGE(PG8_SB(1, 1), b3 + hstep, voffB); PG8_STAGE(PG8_SA(1, 0), a3, voffA);
            PG8_WAIT_V(8); PG8_WAIT_L(0); PG8_BAR; PG8_MMA(1, 0, At, B0); PG8_MMA(1, 1, At, B1); PG8_BAR; PG8_SCHED;
            } else {
            PG8_LDB(B0, 0, 0); PG8_SCHED; PG8_LDA(At, 0, 0); PG8_STAGE(PG8_SA(1, 1), a1 + hstep, voffA);
            PG8_WAIT_L(8); PG8_BAR; PG8_WAIT_L(0); PG8_MMA(0, 0, At, B0); PG8_BAR; PG8_SCHED;
            PG8_LDB(B1, 0, 1); PG8_STAGE(PG8_SB(0, 0), b2, voffB);
            PG8_BAR; PG8_WAIT_L(0); PG8_MMA(0, 1, At, B1); PG8_BAR;
            PG8_LDA(At, 0, 1); PG8_STAGE(PG8_SA(0, 0), a2, voffA);
            PG8_BAR; PG8_WAIT_L(0); PG8_MMA(1, 0, At, B0); PG8_BAR; PG8_SCHED;
            PG8_STAGE(PG8_SB(0, 1), b2 + hstep, voffB);
            PG8_WAIT_V(6); PG8_BAR; PG8_MMA(1, 1, At, B1); PG8_BAR;
            PG8_LDB(B0, 1, 0); PG8_SCHED; PG8_LDA(At, 1, 0); PG8_STAGE(PG8_SA(0, 1), a2 + hstep, voffA);
            PG8_WAIT_L(8); PG8_BAR; PG8_WAIT_L(0); PG8_MMA(0, 0, At, B0); PG8_BAR; PG8_SCHED;
            PG8_LDB(B1, 1, 1); PG8_STAGE(PG8_SB(1, 0), b3, voffB);
            PG8_BAR; PG8_WAIT_L(0); PG8_MMA(0, 1, At, B1); PG8_BAR;
            PG8_LDA(At, 1, 1); PG8_STAGE(PG8_SA(1, 0), a3, voffA);
            PG8_BAR; PG8_WAIT_L(0); PG8_MMA(1, 0, At, B0); PG8_BAR; PG8_SCHED;
            PG8_STAGE(PG8_SB(1, 1), b3 + hstep, voffB);
            PG8_WAIT_V(6); PG8_BAR; PG8_MMA(1, 1, At, B1); PG8_BAR;
            }
        }
        if constexpr (ALIGN_EPI) { if (wr == 0) PG8_BAR; }
        if constexpr (!Epi::AFTER_DRAIN) { E(acc, cur, wr, wc, fr, fq); S.done(cur); }
        if (!has_next) break;
#pragma unroll
        for (int a = 0; a < 2; ++a)
#pragma unroll
            for (int b = 0; b < 2; ++b)
#pragma unroll
                for (int m = 0; m < 4; ++m)
#pragma unroll
                    for (int n = 0; n < 2; ++n) acc[a][b][m][n] = (f32x4){0.f, 0.f, 0.f, 0.f};
        cur = nxt; cA = nA; cB = nB; ++ui;
        if constexpr (ALIGN_EPI) { if (wr == 1) PG8_BAR; }
    }
    PG8_WAIT_V(0);
    if constexpr (!ALIGN_EPI) { if (wr == 0) PG8_BAR; }
    PG8_BAR;
    if constexpr (Epi::AFTER_DRAIN) { E.fused(acc, cur, wr, wc, fr, fq, lds, wid, lane); S.done(cur); }
#undef PG8_SA
#undef PG8_SB
#undef PG8_STAGE
#undef PG8_LDA
#undef PG8_LDB
#undef PG8_MMA
#undef PG8_WAIT_V
#undef PG8_WAIT_L
#undef PG8_BAR
#undef PG8_SCHED
}
}
using pg8::bf16_t; using pg8::bf16x8; using pg8::f32x4; using pg8::u32x4; using pg8::Unit;
#define LAS __attribute__((address_space(3)))
typedef float f32x16 __attribute__((ext_vector_type(16)));
typedef unsigned u32x2 __attribute__((ext_vector_type(2)));
typedef short v4i16_t __attribute__((ext_vector_type(4)));

constexpr int NB = 16, SEQ = 4096, DM = 1024, NMETA = 16, MREAL = NB * SEQ  , MTOT = MREAL + 256  , NPOS = SEQ + NMETA  ;
constexpr int INCOLS = 7168, DFF = 4096;
constexpr float EPS = 1e-6f;
constexpr float C2 = 0.125f * 1.4426950408889634f;
constexpr size_t MiB = 1u << 20;
constexpr size_t WS_CTL = 0;
constexpr size_t WS_COS = 1 * MiB, WS_SIN = 2 * MiB;
constexpr size_t WS_PART1 = 3 * MiB, WS_PART2 = 7 * MiB;
constexpr size_t WS_WIN = 12 * MiB, WS_WRNN = 26 * MiB, WS_WATT = 28 * MiB, WS_WO = 30 * MiB, WS_W1 = 32 * MiB, WS_W2 = 40 * MiB, WS_WG = 48 * MiB;
constexpr size_t WS_SEG = 50 * MiB, SEG_BYTES = 129 * MiB, SEG_ELEMS = SEG_BYTES / 2;
constexpr size_t WS_END = WS_SEG + 7 * SEG_BYTES;
constexpr int LDS_BYTES = 147456, MISC_OFF = 131072 + 320;

__device__ const float INV_FREQ[32] = {1.000000000e+00f,7.498942018e-01f,5.623413324e-01f,4.216965139e-01f,3.162277639e-01f,2.371373922e-01f,1.778279394e-01f,1.333521456e-01f,1.000000015e-01f,7.498941571e-02f,5.623412877e-02f,4.216964915e-02f,3.162277862e-02f,2.371373586e-02f,1.778279431e-02f,1.333521493e-02f,9.999999776e-03f,7.498942316e-03f,5.623413250e-03f,4.216964822e-03f,3.162277862e-03f,2.371373819e-03f,1.778279431e-03f,1.333521446e-03f,1.000000047e-03f,7.498941850e-04f,5.623413017e-04f,4.216965463e-04f,3.162277862e-04f,2.371373848e-04f,1.778279402e-04f,1.333521504e-04f};

__device__ __forceinline__ unsigned f2bf(float f) { unsigned u = __builtin_bit_cast(unsigned, f); return (u + 0x7fffu + ((u >> 16) & 1u)) >> 16; }
typedef float f32x2_t __attribute__((ext_vector_type(2))); typedef __bf16 bf16x2_t __attribute__((ext_vector_type(2)));
__device__ __forceinline__ unsigned pk2(float lo, float hi) { f32x2_t v = {lo, hi}; bf16x2_t b = __builtin_convertvector(v, bf16x2_t); return __builtin_bit_cast(unsigned, b); }
__device__ __forceinline__ float bflo(unsigned w) { return __uint_as_float(w << 16); }
__device__ __forceinline__ float bfhi(unsigned w) { return __uint_as_float(w & 0xffff0000u); }
__device__ __forceinline__ float fsigmoid(float x) { return __builtin_amdgcn_rcpf(1.0f + __builtin_amdgcn_exp2f(-1.4426950408889634f * x)); }
__device__ __forceinline__ float gelu_tanh(float x) { const float z = 1.5957691216057308f * (x + 0.044715f * x * x * x); return x * fsigmoid(z); }
__device__ __forceinline__ float wave_sum(float v) {
#pragma unroll
    for (int o = 1; o < 64; o <<= 1) v += __shfl_xor(v, o);
    return v;
}
#define MEMFENCE() asm volatile("" ::: "memory")

struct EpiProj {
    static constexpr bool PERM = true, AFTER_DRAIN = false, HAS_MID = false;
    bf16_t* seg0; const float* cosT; const float* sinT;
    __device__ __forceinline__ void operator()(const f32x4 (&acc)[2][2][4][2], const Unit& u, int wr, int wc, int fr, int fq) const {
        const int seg = u.pn >> 2, colt = (u.pn & 3) * 256;
        bf16_t* base = seg0 + (size_t)seg * SEG_ELEMS;
        const int col0 = colt + wc * 32 + 8 * fq, row0 = u.pm * 256 + wr * 64 + fr;
        if (seg == 2 || seg == 3) {
            const float sc = (seg == 2) ? C2 : 1.0f;
            const int fi = 4 * (4 * (wc & 1) + fq);
#pragma unroll
            for (int ai = 0; ai < 2; ++ai)
#pragma unroll
                for (int m = 0; m < 4; ++m) {
                    const int row = row0 + ai * 128 + m * 16;
                    int pos = row < MREAL ? NMETA + (row & (SEQ - 1)) : row - MREAL; pos = pos < NPOS ? pos : NPOS - 1;
                    const f32x4 cs = *(const f32x4*)(cosT + pos * 32 + fi), sn = *(const f32x4*)(sinT + pos * 32 + fi);
                    bf16_t* rowp = base + (size_t)row * DM + col0;
#pragma unroll
                    for (int bj = 0; bj < 2; ++bj) {
                        const f32x4 v0 = acc[ai][bj][m][0], v1 = acc[ai][bj][m][1];
                        const f32x4 o0 = (v0 * cs - v1 * sn) * sc, o1 = (v1 * cs + v0 * sn) * sc;
                        u32x4 w; w.x = pk2(o0[0], o0[1]); w.y = pk2(o0[2], o0[3]); w.z = pk2(o1[0], o1[1]); w.w = pk2(o1[2], o1[3]);
                        *(u32x4*)(rowp + bj * 128) = w;
                    }
                    if (m & 1) MEMFENCE();
                }
        } else {
            const int mode = (seg == 1) ? 1 : (seg >= 5 ? 2 : 0);
#pragma unroll
            for (int ai = 0; ai < 2; ++ai)
#pragma unroll
                for (int m = 0; m < 4; ++m) {
                    const int row = row0 + ai * 128 + m * 16;
                    bf16_t* rowp = base + (size_t)row * DM + col0;
#pragma unroll
                    for (int bj = 0; bj < 2; ++bj) {
                        f32x4 v0 = acc[ai][bj][m][0], v1 = acc[ai][bj][m][1];
                        if (mode == 1) {
#pragma unroll
                            for (int i = 0; i < 4; ++i) { v0[i] = gelu_tanh(v0[i]); v1[i] = gelu_tanh(v1[i]); }
                        } else if (mode == 2) {
#pragma unroll
                            for (int i = 0; i < 4; ++i) { v0[i] = fsigmoid(v0[i]); v1[i] = fsigmoid(v1[i]); }
                        }
                        u32x4 w; w.x = pk2(v0[0], v0[1]); w.y = pk2(v0[2], v0[3]); w.z = pk2(v1[0], v1[1]); w.w = pk2(v1[2], v1[3]);
                        *(u32x4*)(rowp + bj * 128) = w;
                    }
                }
        }
    }
};
struct EpiMerge {
    static constexpr bool PERM = true, AFTER_DRAIN = false, HAS_MID = true;
    bf16_t* out; const bf16_t* gr; const bf16_t* ga;
    __device__ __forceinline__ void mid(f32x4 (&acc)[2][2][4][2], const Unit& u, int wr, int wc, int fr, int fq) const {
        int col0 = u.pn * 256 + wc * 32 + 8 * fq, row0 = u.pm * 256 + wr * 64 + fr;
        asm volatile("" : "+v"(col0), "+v"(row0));
#pragma unroll
        for (int ai = 0; ai < 2; ++ai)
#pragma unroll
            for (int m = 0; m < 4; ++m) {
                const size_t off = (size_t)(row0 + ai * 128 + m * 16) * DM + col0;
#pragma unroll
                for (int bj = 0; bj < 2; ++bj) {
                    const u32x4 r = *(const u32x4*)(gr + off + bj * 128), a = *(const u32x4*)(ga + off + bj * 128);
                    const unsigned rw[4] = {r.x, r.y, r.z, r.w}, aw[4] = {a.x, a.y, a.z, a.w};
#pragma unroll
                    for (int i = 0; i < 4; ++i) {
                        const float q0 = bflo(rw[i]) * __builtin_amdgcn_rcpf(fmaxf(bflo(aw[i]), 1e-30f)), q1 = bfhi(rw[i]) * __builtin_amdgcn_rcpf(fmaxf(bfhi(aw[i]), 1e-30f));
                        acc[ai][bj][m][i >> 1][2 * (i & 1)] *= q0; acc[ai][bj][m][i >> 1][2 * (i & 1) + 1] *= q1;
                    }
                }
                MEMFENCE();
            }
    }
    __device__ __forceinline__ void operator()(const f32x4 (&acc)[2][2][4][2], const Unit& u, int wr, int wc, int fr, int fq) const {
        const int col0 = u.pn * 256 + wc * 32 + 8 * fq, row0 = u.pm * 256 + wr * 64 + fr;
#pragma unroll
        for (int ai = 0; ai < 2; ++ai)
#pragma unroll
            for (int m = 0; m < 4; ++m) {
                const size_t off = (size_t)(row0 + ai * 128 + m * 16) * DM + col0;
#pragma unroll
                for (int bj = 0; bj < 2; ++bj) {
                    const u32x4 g = *(const u32x4*)(ga + off + bj * 128);
                    f32x4 v0 = acc[ai][bj][m][0], v1 = acc[ai][bj][m][1];
                    v0[0] *= bflo(g.x); v0[1] *= bfhi(g.x); v0[2] *= bflo(g.y); v0[3] *= bfhi(g.y);
                    v1[0] *= bflo(g.z); v1[1] *= bfhi(g.z); v1[2] *= bflo(g.w); v1[3] *= bfhi(g.w);
                    u32x4 w; w.x = pk2(v0[0], v0[1]); w.y = pk2(v0[2], v0[3]); w.z = pk2(v1[0], v1[1]); w.w = pk2(v1[2], v1[3]);
                    *(u32x4*)(out + off + bj * 128) = w;
                }
                MEMFENCE();
            }
    }
};
template <bool FIRST> struct EpiRes {
    static constexpr bool PERM = true, AFTER_DRAIN = false, HAS_MID = false;
    const float* basef; const bf16_t* baseh; bf16_t* out; bf16_t* hn; const float* g; float* part;
    __device__ __forceinline__ void operator()(const f32x4 (&acc)[2][2][4][2], const Unit& u, int wr, int wc, int fr, int fq) const {
        const int col0 = u.pn * 256 + wc * 32 + 8 * fq, row0 = u.pm * 256 + wr * 64 + fr;
#pragma unroll
        for (int ai = 0; ai < 2; ++ai)
#pragma unroll
            for (int m = 0; m < 4; ++m) {
                const int row = row0 + ai * 128 + m * 16; const size_t off = (size_t)row * DM + col0;
                float ss = 0.f;
#pragma unroll
                for (int bj = 0; bj < 2; ++bj) {
                    f32x4 h0, h1;
                    if (FIRST) { h0 = __builtin_nontemporal_load((const f32x4*)(basef + off + bj * 128)); h1 = __builtin_nontemporal_load((const f32x4*)(basef + off + bj * 128 + 4)); }
                    else { const u32x4 p = __builtin_nontemporal_load((const u32x4*)(baseh + off + bj * 128)); h0 = (f32x4){bflo(p.x), bfhi(p.x), bflo(p.y), bfhi(p.y)}; h1 = (f32x4){bflo(p.z), bfhi(p.z), bflo(p.w), bfhi(p.w)}; }
                    h0 += acc[ai][bj][m][0]; h1 += acc[ai][bj][m][1];
                    u32x4 w; w.x = pk2(h0[0], h0[1]); w.y = pk2(h0[2], h0[3]); w.z = pk2(h1[0], h1[1]); w.w = pk2(h1[2], h1[3]);
                    *(u32x4*)(out + off + bj * 128) = w;
                    ss += (h0[0] * h0[0] + h0[1] * h0[1]) + (h0[2] * h0[2] + h0[3] * h0[3]) + (h1[0] * h1[0] + h1[1] * h1[1]) + (h1[2] * h1[2] + h1[3] * h1[3]);
                    if (FIRST) {
                        const f32x4 g0 = *(const f32x4*)(g + col0 + bj * 128), g1 = *(const f32x4*)(g + col0 + bj * 128 + 4);
                        const f32x4 a = h0 * g0, b = h1 * g1;
                        u32x4 w2; w2.x = pk2(a[0], a[1]); w2.y = pk2(a[2], a[3]); w2.z = pk2(b[0], b[1]); w2.w = pk2(b[2], b[3]);
                        *(u32x4*)(hn + off + bj * 128) = w2;
                    }
                }
                ss += __shfl_xor(ss, 16); ss += __shfl_xor(ss, 32);
                if (fq == 0) part[(size_t)row * 16 + u.pn * 4 + wc] = ss;
                MEMFENCE();
            }
    }
};
struct EpiFF1 {
    static constexpr bool PERM = true, AFTER_DRAIN = false, HAS_MID = false;
    bf16_t* ff; const float* part;
    __device__ __forceinline__ void operator()(const f32x4 (&acc)[2][2][4][2], const Unit& u, int wr, int wc, int fr, int fq) const {
        const int col0 = u.pn * 256 + wc * 32 + 8 * fq, row0 = u.pm * 256 + wr * 64 + fr;
#pragma unroll
        for (int ai = 0; ai < 2; ++ai)
#pragma unroll
            for (int m = 0; m < 4; ++m) {
                const int row = row0 + ai * 128 + m * 16;
                const f32x4* pp = (const f32x4*)(part + (size_t)row * 16);
                const f32x4 p0 = pp[0], p1 = pp[1], p2 = pp[2], p3 = pp[3];
                const float s = ((p0[0] + p0[1]) + (p0[2] + p0[3])) + ((p1[0] + p1[1]) + (p1[2] + p1[3])) + ((p2[0] + p2[1]) + (p2[2] + p2[3])) + ((p3[0] + p3[1]) + (p3[2] + p3[3]));
                const float rstd = __builtin_amdgcn_rsqf(s * (1.0f / DM) + EPS);
                bf16_t* rowp = ff + (size_t)row * DFF + col0;
#pragma unroll
                for (int bj = 0; bj < 2; ++bj) {
                    f32x4 v0 = acc[ai][bj][m][0] * rstd, v1 = acc[ai][bj][m][1] * rstd;
#pragma unroll
                    for (int i = 0; i < 4; ++i) { v0[i] = fmaxf(v0[i], 0.f); v0[i] *= v0[i]; v1[i] = fmaxf(v1[i], 0.f); v1[i] *= v1[i]; }
                    u32x4 w; w.x = pk2(v0[0], v0[1]); w.y = pk2(v0[2], v0[3]); w.z = pk2(v1[0], v1[1]); w.w = pk2(v1[2], v1[3]);
                    __builtin_nontemporal_store(w, (u32x4*)(rowp + bj * 128));
                }
                if (m & 1) MEMFENCE();
            }
    }
};

struct Ctx {
    const float* in[23]; float* out; unsigned char* ws;
};
struct Args { const float* in[23]; float* out; unsigned char* ws; int mask; int pad; };

__device__ __forceinline__ void p0_transpose_item(const float* W, int K, int N, bf16_t* WT, int perm_lo, int perm_hi, LAS float* scr, int item, int lane, int ldk = 0) {
    if (ldk == 0) ldk = K;
    const int nblk = N / 32, kb = item / nblk, nb = item % nblk, k0 = 64 * kb, n0 = 32 * nb;
#pragma unroll 8
    for (int i = 0; i < 32; ++i) { const int kk = 2 * i + (lane >> 5); scr[kk * 33 + (lane & 31)] = W[(size_t)(k0 + kk) * N + n0 + (lane & 31)]; }
    asm volatile("s_waitcnt lgkmcnt(0)" ::: "memory");
    const int c = lane & 7;
#pragma unroll
    for (int j = 0; j < 4; ++j) { const int n = (lane >> 3) + 8 * j; const LAS float* s = scr + (8 * c) * 33 + n;
        u32x4 o; o.x = f2bf(s[0 * 33]) | (f2bf(s[1 * 33]) << 16); o.y = f2bf(s[2 * 33]) | (f2bf(s[3 * 33]) << 16); o.z = f2bf(s[4 * 33]) | (f2bf(s[5 * 33]) << 16); o.w = f2bf(s[6 * 33]) | (f2bf(s[7 * 33]) << 16);
        int nl = n0 + n;
        if (nl >= perm_lo && nl < perm_hi) { const int jj = nl & 63; const int gg = (jj < 32) ? (8 * (jj >> 2) + (jj & 3)) : (8 * ((jj - 32) >> 2) + 4 + (jj & 3)); nl = (nl & ~63) + gg; }
        *(u32x4*)(WT + (size_t)nl * ldk + k0 + 8 * c) = o; }
    asm volatile("s_waitcnt lgkmcnt(0)" ::: "memory");
}
__device__ __forceinline__ void rms_row_to_bf16(const float* xrow, const float* g, bf16_t* orow, int lane) {
    const f32x4* xr = (const f32x4*)xrow + lane; const f32x4* gr = (const f32x4*)g + lane;
    f32x4 v[4]; float s = 0.f;
#pragma unroll
    for (int j = 0; j < 4; ++j) { v[j] = __builtin_nontemporal_load(xr + 64 * j); s += (v[j][0] * v[j][0] + v[j][1] * v[j][1]) + (v[j][2] * v[j][2] + v[j][3] * v[j][3]); }
    const float rstd = 1.0f / sqrtf(wave_sum(s) * (1.0f / DM) + EPS);
    u32x2* o8 = (u32x2*)orow + lane;
#pragma unroll
    for (int j = 0; j < 4; ++j) { const f32x4 gg = gr[64 * j]; u32x2 w; w.x = pk2(v[j][0] * rstd * gg[0], v[j][1] * rstd * gg[1]); w.y = pk2(v[j][2] * rstd * gg[2], v[j][3] * rstd * gg[3]); o8[64 * j] = w; }
}
__device__ __forceinline__ void p0_prologue(const Args& A, LAS unsigned char* lds, int tid, int lane, int wave) {
    unsigned char* ws = A.ws;
    LAS float* scr = (LAS float*)(lds + wave * 16384);
    const int gw = blockIdx.x * 8 + wave, NGW = gridDim.x * 8;
    constexpr int I_IN = 16 * (INCOLS / 32), I_SQ = 16 * 32, I_1 = 16 * (DFF / 32), I_2 = (DFF / 64) * 32, I_G = 16 * 8;
    constexpr int NITEMS = I_IN + 3 * I_SQ + I_1 + I_2 + I_G;
    for (int it = gw; it < NITEMS; it += NGW) {
        int r = it;
        if (r < I_IN) { p0_transpose_item(A.in[3], DM, INCOLS, (bf16_t*)(ws + WS_WIN), 2048, 4096, scr, r, lane); continue; } r -= I_IN;
        if (r < I_SQ) { p0_transpose_item(A.in[16], DM, DM, (bf16_t*)(ws + WS_WRNN), 0, 0, scr, r, lane, 2 * DM); continue; } r -= I_SQ;
        if (r < I_SQ) { p0_transpose_item(A.in[17], DM, DM, (bf16_t*)(ws + WS_WRNN) + DM, 0, 0, scr, r, lane, 2 * DM); continue; } r -= I_SQ;
        if (r < I_SQ) { p0_transpose_item(A.in[18], DM, DM, (bf16_t*)(ws + WS_WO), 0, 0, scr, r, lane); continue; } r -= I_SQ;
        if (r < I_1) { p0_transpose_item(A.in[20], DM, DFF, (bf16_t*)(ws + WS_W1), 0, 0, scr, r, lane); continue; } r -= I_1;
        if (r < I_2) { p0_transpose_item(A.in[21], DFF, DM, (bf16_t*)(ws + WS_W2), 0, 0, scr, r, lane); continue; } r -= I_2;
        { const int blk = r >> 3, sub = r & 7;
          const int gate = blk >> 3, n = blk & 7;
          p0_transpose_item(A.in[gate ? 8 : 6] + (size_t)n * 128 * 128, 128, 128, (bf16_t*)(ws + WS_WG) + (size_t)(n * 2 + gate) * 128 * 128, 0, 0, scr, sub, lane); }
    }
    bf16_t* XN = (bf16_t*)A.out;
    for (int m = gw; m < MTOT; m += NGW) {
        if (m < MREAL) rms_row_to_bf16(A.in[0] + (size_t)m * DM, A.in[2], XN + (size_t)m * DM, lane);
        else if (m < MREAL + NMETA) rms_row_to_bf16(A.in[1] + (size_t)(m - MREAL) * DM, A.in[2], XN + (size_t)m * DM, lane);
        else { u32x2* o8 = (u32x2*)(XN + (size_t)m * DM) + lane;
#pragma unroll
            for (int j = 0; j < 4; ++j) o8[64 * j] = (u32x2){0u, 0u}; }
    }
    float* cosT = (float*)(ws + WS_COS); float* sinT = (float*)(ws + WS_SIN);
    for (int i = blockIdx.x * 512 + tid; i < NPOS * 32; i += gridDim.x * 512) {
        const int pos = i >> 5, fi = i & 31;
        const float ang = (float)pos * INV_FREQ[fi];
        double rev = (double)ang * 0.15915494309189535; rev -= __builtin_rint(rev);
        const float rf = (float)rev;
        cosT[i] = __builtin_amdgcn_cosf(rf); sinT[i] = __builtin_amdgcn_sinf(rf);
    }
    if (blockIdx.x == 0 && wave == 0) {
        const float a = A.in[11][lane] * A.in[12][lane], b = A.in[13][lane] * A.in[14][lane];
        const float sa = wave_sum(a), sb = wave_sum(b);
        if (lane == 0) ((float*)(ws + WS_CTL))[64] = __expf(sa) - __expf(sb) + 0.2f;
    }
}

__device__ __forceinline__ size_t seqrow(int b, int p) { return p < NMETA ? (size_t)(MREAL + p) : (size_t)b * SEQ + (size_t)(p - NMETA); }
__device__ __forceinline__ void scan_item(int b, int n, const Args& A, LAS unsigned char* lds) {
    const int tid = threadIdx.x, lane = tid & 63, w = __builtin_amdgcn_readfirstlane(tid >> 6), l15 = lane & 15, q4 = lane >> 4;
    constexpr int RP = 272;
    LAS unsigned char* XRt = lds;
    LAS unsigned char* GRt = lds + 18432;
    LAS unsigned char* At = lds + 18432 + 17408;
    LAS float* XCf = (LAS float*)(lds + 18432 + 2 * 17408);
    LAS float* CW = (LAS float*)(lds + 18432 + 2 * 17408 + 33792);
    unsigned char* ws = A.ws;
    const bf16_t* XR = (const bf16_t*)(ws + WS_SEG); const bf16_t* GR = (const bf16_t*)(ws + WS_SEG + SEG_BYTES); bf16_t* YR = (bf16_t*)A.out;
    for (int i = tid; i < 640; i += 512) { const int k = i >> 7, c = i & 127; CW[i] = k < 4 ? A.in[4][k * DM + n * 128 + c] : A.in[5][n * 128 + c]; }
    const int dl = 16 * w + l15, ch = n * 128 + dl;
    bf16x8 bw[2][4];
    { const bf16_t* WG = (const bf16_t*)(ws + WS_WG);
#pragma unroll
      for (int gate = 0; gate < 2; ++gate)
#pragma unroll
          for (int ks = 0; ks < 4; ++ks) bw[gate][ks] = *(const bf16x8*)(WG + ((size_t)(n * 2 + gate) * 128 + dl) * 128 + 32 * ks + 8 * q4); }
    const float ba = A.in[7][ch], bx = A.in[9][ch];
    float sp8;
    { const float e = __expf(-A.in[10][ch]);
      const float sp = (e < 0.05f) ? e * (1.0f + e * (-0.5f + e * (0.33333333f + e * (-0.25f + e * 0.2f)))) : 0.6931471805599453f * __builtin_amdgcn_logf(1.0f + e);
      sp8 = 8.0f * sp; }
    float hprev = 0.f;
    int rr0 = tid >> 4, c16 = tid & 15;
    asm volatile("" : "+v"(rr0), "+v"(c16));
    u32x4 xrg[3], grg[2];
    const u32x4 zero4 = (u32x4){0u, 0u, 0u, 0u};
#define SCAN_LOAD(i_) do { const int p0_ = NMETA + 64 * ((i_) - 1); \
        _Pragma("unroll") for (int j = 0; j < 3; ++j) { const int rr = rr0 + 32 * j; const int p = p0_ - 3 + rr; \
            xrg[j] = (rr < 67 && p >= 0) ? *(const u32x4*)(XR + seqrow(b, p) * DM + n * 128 + c16 * 8) : zero4; } \
        _Pragma("unroll") for (int j = 0; j < 2; ++j) { const int p = p0_ + rr0 + 32 * j; \
            grg[j] = (p >= 0) ? *(const u32x4*)(GR + seqrow(b, p) * DM + n * 128 + c16 * 8) : zero4; } } while (0)
    SCAN_LOAD(0);
    for (int i = 0; i <= 64; ++i) {
#pragma unroll
        for (int j = 0; j < 3; ++j) { const int rr = rr0 + 32 * j; if (rr < 67) *(LAS u32x4*)(XRt + rr * RP + c16 * 16) = xrg[j]; }
#pragma unroll
        for (int j = 0; j < 2; ++j) *(LAS u32x4*)(GRt + (rr0 + 32 * j) * RP + c16 * 16) = grg[j];
        __syncthreads();
        if (i < 64) SCAN_LOAD(i + 1);
#pragma unroll
        for (int j = 0; j < 2; ++j) {
            const int tt = rr0 + 32 * j;
            float a8[8];
            { const f32x4 b0 = *(const LAS f32x4*)(CW + 512 + 8 * c16), b1 = *(const LAS f32x4*)(CW + 512 + 8 * c16 + 4);
              a8[0] = b0[0]; a8[1] = b0[1]; a8[2] = b0[2]; a8[3] = b0[3]; a8[4] = b1[0]; a8[5] = b1[1]; a8[6] = b1[2]; a8[7] = b1[3]; }
#pragma unroll
            for (int k = 0; k < 4; ++k) {
                const u32x4 xv = *(const LAS u32x4*)(XRt + (tt + k) * RP + c16 * 16);
                const f32x4 w0 = *(const LAS f32x4*)(CW + k * 128 + 8 * c16), w1 = *(const LAS f32x4*)(CW + k * 128 + 8 * c16 + 4);
                a8[0] += w0[0] * bflo(xv.x); a8[1] += w0[1] * bfhi(xv.x); a8[2] += w0[2] * bflo(xv.y); a8[3] += w0[3] * bfhi(xv.y);
                a8[4] += w1[0] * bflo(xv.z); a8[5] += w1[1] * bfhi(xv.z); a8[6] += w1[2] * bflo(xv.w); a8[7] += w1[3] * bfhi(xv.w);
            }
            u32x4 pw; pw.x = pk2(a8[0], a8[1]); pw.y = pk2(a8[2], a8[3]); pw.z = pk2(a8[4], a8[5]); pw.w = pk2(a8[6], a8[7]);
            *(LAS u32x4*)(At + tt * RP + c16 * 16) = pw;
            *(LAS f32x4*)(XCf + tt * 132 + 8 * c16) = (f32x4){a8[0], a8[1], a8[2], a8[3]};
            *(LAS f32x4*)(XCf + tt * 132 + 8 * c16 + 4) = (f32x4){a8[4], a8[5], a8[6], a8[7]};
        }
        __syncthreads();
        f32x4 ar[4], ag[4];
#pragma unroll
        for (int mb = 0; mb < 4; ++mb) { ar[mb] = (f32x4){0.f, 0.f, 0.f, 0.f}; ag[mb] = (f32x4){0.f, 0.f, 0.f, 0.f};
#pragma unroll
            for (int ks = 0; ks < 4; ++ks) { const bf16x8 a = *(const LAS bf16x8*)(At + (16 * mb + l15) * RP + (32 * ks + 8 * q4) * 2);
                ar[mb] = __builtin_amdgcn_mfma_f32_16x16x32_bf16(a, bw[0][ks], ar[mb], 0, 0, 0);
                ag[mb] = __builtin_amdgcn_mfma_f32_16x16x32_bf16(a, bw[1][ks], ag[mb], 0, 0, 0); } }
#pragma unroll
        for (int mb = 0; mb < 4; ++mb) {
            float hl[4], cum[4];
#pragma unroll
            for (int j = 0; j < 4; ++j) {
                const int tl = 16 * mb + 4 * q4 + j;
                const float r = fsigmoid(ar[mb][j] + ba), ig = fsigmoid(ag[mb][j] + bx);
                const float la = -sp8 * r;
                float a = __builtin_amdgcn_exp2f(1.4426950408889634f * la);
                const float x2 = 2.0f * la;
                const float om = (x2 > -0.01f) ? -x2 * (1.0f + x2 * (0.5f + x2 * 0.16666667f)) : 1.0f - __builtin_amdgcn_exp2f(1.4426950408889634f * x2);
                float uu = __builtin_amdgcn_sqrtf(om) * ig * XCf[tl * 132 + dl];
                if (i == 0 && tl < 48) { uu = 0.f; a = 1.f; }
                if (j == 0) { hl[0] = uu; cum[0] = a; } else { hl[j] = a * hl[j - 1] + uu; cum[j] = cum[j - 1] * a; }
            }
            float P = cum[3], H = hl[3];
            { const float Pp = __shfl_up(P, 16), Hp = __shfl_up(H, 16); if (q4 >= 1) { H = P * Hp + H; P = P * Pp; } }
            { const float Pp = __shfl_up(P, 32), Hp = __shfl_up(H, 32); if (q4 >= 2) { H = P * Hp + H; P = P * Pp; } }
            const float Pe = __shfl_up(P, 16), He = __shfl_up(H, 16);
            const float hin = (q4 == 0) ? hprev : (Pe * hprev + He);
            const float Pl = __shfl(P, 48 + l15), Hl = __shfl(H, 48 + l15);
            hprev = Pl * hprev + Hl;
#pragma unroll
            for (int j = 0; j < 4; ++j) {
                const int tl = 16 * mb + 4 * q4 + j;
                const float h = hl[j] + cum[j] * hin;
                LAS unsigned short* gp = (LAS unsigned short*)(GRt + tl * RP) + dl;
                const float y = __uint_as_float(((unsigned)*gp) << 16) * h;
                *gp = (unsigned short)f2bf(y);
            }
        }
        __syncthreads();
        if (i >= 1) {
#pragma unroll
            for (int j = 0; j < 2; ++j) { const int rr = rr0 + 32 * j; const u32x4 v = *(const LAS u32x4*)(GRt + rr * RP + c16 * 16);
                *(u32x4*)(YR + ((size_t)b * SEQ + 64 * (i - 1) + rr) * (2 * DM) + n * 128 + c16 * 8) = v; }
        }
        __syncthreads();
    }
#undef SCAN_LOAD
}

__device__ __forceinline__ int crow(int r, int hi) { return (r & 3) + 8 * (r >> 2) + 4 * hi; }
constexpr int KP = 272, VP = 320, KB_BYTES = 64 * KP, VB_BYTES = 64 * VP, ABUF = KB_BYTES + VB_BYTES;
struct AttnSt {
    f32x16 o[4]; f32x16 negm; u32x4 pw[4]; float m, l; u32x4 kr[2], vr[2];
};
template <bool GEN> __device__ __forceinline__ void attn_step(AttnSt& st, const int t, const int NT, const int qb, LAS unsigned char* lds, const bf16x8 (&qf)[4],
                                                              const bf16_t* Kg, const bf16_t* Vg, const size_t brow, const int srow0, const int sc16,
                                                              const int koff, const int voff, const int qrel, const int hi) {
    const bool has_next = GEN ? (t + 1 < NT) : true, has_prev = GEN ? (t >= 1) : true;
    if (has_next) { const size_t rb = brow + 64 * t;
#pragma unroll
        for (int jj = 0; jj < 2; ++jj) st.kr[jj] = *(const u32x4*)(Kg + (rb + srow0 + 32 * jj) * DM); }
    { const size_t rb = (GEN && t == 0) ? (size_t)MREAL : brow + 64 * (t - 1);
#pragma unroll
        for (int jj = 0; jj < 2; ++jj) st.vr[jj] = *(const u32x4*)(Vg + (rb + srow0 + 32 * jj) * DM); }
#define VREAD(buf_, g_) do { _Pragma("unroll") for (int e = 0; e < 2; ++e) { \
        vlo[buf_][e] = __builtin_amdgcn_ds_read_tr16_b64_v4i16((LAS v4i16_t*)(vb + (16 * ((g_) >> 1)) * VP + (2 * ((g_) & 1) + e) * 64)); \
        vhi[buf_][e] = __builtin_amdgcn_ds_read_tr16_b64_v4i16((LAS v4i16_t*)(vb + (16 * ((g_) >> 1) + 8) * VP + (2 * ((g_) & 1) + e) * 64)); } } while (0)
    LAS unsigned char* vb = lds + 2 * KB_BYTES + ((t - 1) & 1) * VB_BYTES + voff;
    v4i16_t vlo[2][2], vhi[2][2];
    f32x16 n0, n1;
    {
        LAS unsigned char* Kb = lds + (t & 1) * KB_BYTES + koff;
#pragma unroll
        for (int ks = 0; ks < 4; ++ks) {
            const bf16x8 a0 = *(const LAS bf16x8*)(Kb + 32 * ks), a1 = *(const LAS bf16x8*)(Kb + 32 * KP + 32 * ks);
            if (ks == 0) { n0 = __builtin_amdgcn_mfma_f32_32x32x16_bf16(a0, qf[ks], st.negm, 0, 0, 0); n1 = __builtin_amdgcn_mfma_f32_32x32x16_bf16(a1, qf[ks], st.negm, 0, 0, 0); }
            else { n0 = __builtin_amdgcn_mfma_f32_32x32x16_bf16(a0, qf[ks], n0, 0, 0, 0); n1 = __builtin_amdgcn_mfma_f32_32x32x16_bf16(a1, qf[ks], n1, 0, 0, 0); }
        }
    }
    if (has_prev) VREAD(0, 0);
    if (GEN) {
        if (t == 0) {
#pragma unroll
            for (int r = 0; r < 16; ++r) { if (r >= 8) n0[r] = -INFINITY; n1[r] = -INFINITY; }
        } else if (t - 1 >= 2 * qb) {
            const int kb0 = 64 * (t - 1 - 2 * qb);
#pragma unroll
            for (int r = 0; r < 16; ++r) { const int kk = kb0 + crow(r, hi); if (kk > qrel) n0[r] = -INFINITY; if (kk + 32 > qrel) n1[r] = -INFINITY; }
        }
    }
    float rm;
    { float a = fmaxf(fmaxf(n0[0], n0[1]), n1[0]), b = fmaxf(fmaxf(n0[2], n0[3]), n1[1]); a = fmaxf(fmaxf(a, n1[2]), n1[3]);
#pragma unroll
      for (int r = 4; r < 16; r += 4) { a = fmaxf(fmaxf(a, n0[r]), n0[r + 1]); b = fmaxf(fmaxf(b, n0[r + 2]), n0[r + 3]); a = fmaxf(fmaxf(a, n1[r]), n1[r + 1]); b = fmaxf(fmaxf(b, n1[r + 2]), n1[r + 3]); }
      rm = fmaxf(a, b); }
    { const auto rr = __builtin_amdgcn_permlane32_swap(__float_as_uint(rm), __float_as_uint(rm), false, false); rm = fmaxf(__uint_as_float(rr[0]), __uint_as_float(rr[1])); }
    const bool grow = (GEN && t == 0) ? true : (rm > 8.0f);
    const bool any_grow = __any(grow);
    float alpha = 1.0f;
    if (any_grow) {
        const float dl = grow ? rm : 0.f;
        alpha = (GEN && t == 0) ? 0.f : __builtin_amdgcn_exp2f(-dl);
        st.m += dl;
#pragma unroll
        for (int r = 0; r < 16; ++r) { n0[r] -= dl; n1[r] -= dl; st.negm[r] = -st.m; }
    }
    float sa = 0.f, sb = 0.f;
    u32x4 npw[4];
#pragma unroll
    for (int g8 = 0; g8 < 8; ++g8) {
        if (has_prev && g8 < 7) VREAD((g8 + 1) & 1, g8 + 1);
        __builtin_amdgcn_sched_barrier(0);
        if (has_prev) {
            const bf16x8 pf = __builtin_bit_cast(bf16x8, st.pw[g8 >> 1]);
#pragma unroll
            for (int e = 0; e < 2; ++e) {
                const v4i16_t lo = vlo[g8 & 1][e], hh = vhi[g8 & 1][e];
                const bf16x8 vf = (bf16x8){lo[0], lo[1], lo[2], lo[3], hh[0], hh[1], hh[2], hh[3]};
                st.o[2 * (g8 & 1) + e] = __builtin_amdgcn_mfma_f32_32x32x16_bf16(vf, pf, st.o[2 * (g8 & 1) + e], 0, 0, 0);
            }
        }
        {
            const int r = 2 * g8;
            const float x0 = __builtin_amdgcn_exp2f(n0[r]), x1 = __builtin_amdgcn_exp2f(n0[r + 1]);
            const float y0 = __builtin_amdgcn_exp2f(n1[r]), y1 = __builtin_amdgcn_exp2f(n1[r + 1]);
            sa += x0 + y0; sb += x1 + y1;
            npw[g8 >> 2][g8 & 3] = pk2(x0, x1); npw[2 + (g8 >> 2)][g8 & 3] = pk2(y0, y1);
        }
        __builtin_amdgcn_sched_barrier(0);
    }
#undef VREAD
    st.l = st.l * alpha + (sa + sb);
    if (any_grow) {
#pragma unroll
        for (int e = 0; e < 4; ++e)
#pragma unroll
            for (int r = 0; r < 16; ++r) st.o[e][r] *= alpha;
    }
#pragma unroll
    for (int k = 0; k < 4; ++k) st.pw[k] = npw[k];
    if (has_next) {
#pragma unroll
        for (int jj = 0; jj < 2; ++jj) *(LAS u32x4*)(lds + ((t + 1) & 1) * KB_BYTES + (srow0 + 32 * jj) * KP + sc16 * 16) = st.kr[jj]; }
#pragma unroll
    for (int jj = 0; jj < 2; ++jj) *(LAS u32x4*)(lds + 2 * KB_BYTES + (t & 1) * VB_BYTES + (srow0 + 32 * jj) * VP + sc16 * 16) = st.vr[jj];
    __syncthreads();
}
__device__ __forceinline__ void attn_unit(int b, int h, int qb, const Args& A, float lam, LAS unsigned char* lds) {
    const int tid = threadIdx.x, lane = tid & 63, wid = __builtin_amdgcn_readfirstlane(tid >> 6), c = wid & 1, g = wid >> 1, r32 = lane & 31, hi = lane >> 5;
    unsigned char* ws = A.ws;
    const bf16_t* Q = (const bf16_t*)(ws + WS_SEG + 2 * SEG_BYTES); const bf16_t* K = (const bf16_t*)(ws + WS_SEG + 3 * SEG_BYTES); const bf16_t* V = (const bf16_t*)(ws + WS_SEG + 4 * SEG_BYTES);
    const size_t rowq = (size_t)b * SEQ + qb * 128 + 32 * g + r32;
    bf16x8 qf[4];
#pragma unroll
    for (int ks = 0; ks < 4; ++ks) qf[ks] = __builtin_nontemporal_load((const bf16x8*)(Q + rowq * DM + h * 128 + c * 64 + 16 * ks + 8 * hi));
    AttnSt st;
#pragma unroll
    for (int e = 0; e < 4; ++e)
#pragma unroll
        for (int r = 0; r < 16; ++r) st.o[e][r] = 0.f;
    st.m = 0.f; st.l = 0.f;
#pragma unroll
    for (int r = 0; r < 16; ++r) st.negm[r] = 0.f;
#pragma unroll
    for (int k = 0; k < 4; ++k) st.pw[k] = (u32x4){0u, 0u, 0u, 0u};
    const int NT = 2 * qb + 3;
    int srow0 = tid >> 4, sc16 = tid & 15;
    asm volatile("" : "+v"(srow0), "+v"(sc16));
    const bf16_t* Kg = K + h * 128 + sc16 * 8; const bf16_t* Vg = V + h * 128 + sc16 * 8;
    const size_t brow = (size_t)b * SEQ;
    const int koff = r32 * KP + 128 * c + 16 * hi;
    const int voff = (4 * hi + ((lane & 15) >> 2)) * VP + (16 * ((lane >> 4) & 1) + 4 * (lane & 3)) * 2;
    const int qrel = 32 * g + r32;
    {
#pragma unroll
        for (int jj = 0; jj < 2; ++jj) { const u32x4 k0 = *(const u32x4*)(Kg + ((size_t)MREAL + srow0 + 32 * jj) * DM); *(LAS u32x4*)(lds + (srow0 + 32 * jj) * KP + sc16 * 16) = k0; }
        __syncthreads();
    }
    int t = 0;
    attn_step<true>(st, 0, NT, qb, lds, qf, Kg, Vg, brow, srow0, sc16, koff, voff, qrel, hi);
    for (t = 1; t + 2 < NT; ++t) attn_step<false>(st, t, NT, qb, lds, qf, Kg, Vg, brow, srow0, sc16, koff, voff, qrel, hi);
    for (; t < NT; ++t) attn_step<true>(st, t, NT, qb, lds, qf, Kg, Vg, brow, srow0, sc16, koff, voff, qrel, hi);
    {
        LAS unsigned char* vb = lds + 2 * KB_BYTES + ((NT - 1) & 1) * VB_BYTES + voff;
#pragma unroll
        for (int s = 0; s < 4; ++s) {
            const bf16x8 pf = __builtin_bit_cast(bf16x8, st.pw[s]);
#pragma unroll
            for (int e = 0; e < 4; ++e) {
                const v4i16_t lo = __builtin_amdgcn_ds_read_tr16_b64_v4i16((LAS v4i16_t*)(vb + (16 * s) * VP + e * 64));
                const v4i16_t hh = __builtin_amdgcn_ds_read_tr16_b64_v4i16((LAS v4i16_t*)(vb + (16 * s + 8) * VP + e * 64));
                const bf16x8 vf = (bf16x8){lo[0], lo[1], lo[2], lo[3], hh[0], hh[1], hh[2], hh[3]};
                st.o[e] = __builtin_amdgcn_mfma_f32_32x32x16_bf16(vf, pf, st.o[e], 0, 0, 0);
            }
        }
    }
    __syncthreads();
    float l = st.l; l += __shfl_xor(l, 32);
    const float inv = 1.0f / l;
    LAS float* comb = (LAS float*)lds + g * 4096;
    if (c == 1) {
        const float sc = lam * inv;
#pragma unroll
        for (int e = 0; e < 4; ++e)
#pragma unroll
            for (int r = 0; r < 16; ++r) comb[(e * 16 + r) * 64 + lane] = st.o[e][r] * sc;
    }
    __syncthreads();
    if (c == 0) {
        float ss = 0.f;
#pragma unroll
        for (int e = 0; e < 4; ++e)
#pragma unroll
            for (int r = 0; r < 16; ++r) { const float d = st.o[e][r] * inv - comb[(e * 16 + r) * 64 + lane]; st.o[e][r] = d; ss += d * d; }
        ss += __shfl_xor(ss, 32);
        const float rms = __builtin_amdgcn_rsqf(ss * (1.0f / 128.0f) + EPS) * 0.8f;
        const float* gs = A.in[15];
        bf16_t* orow = (bf16_t*)A.out + rowq * (2 * DM) + DM + h * 128;
#pragma unroll
        for (int e = 0; e < 4; ++e)
#pragma unroll
            for (int rr = 0; rr < 4; ++rr) {
                const int e0 = 32 * e + 8 * rr + 4 * hi;
                const f32x4 gv = *(const f32x4*)(gs + e0);
                u32x2 w; w.x = pk2(st.o[e][4 * rr] * rms * gv[0], st.o[e][4 * rr + 1] * rms * gv[1]); w.y = pk2(st.o[e][4 * rr + 2] * rms * gv[2], st.o[e][4 * rr + 3] * rms * gv[3]);
                *(u32x2*)(orow + e0) = w;
            }
    }
    __syncthreads();
}

#define RLX_AGENT __ATOMIC_RELAXED, __HIP_MEMORY_SCOPE_AGENT
#define XB_TMO      128
#define XB_XCNT(j)  (256  + 64 * (j))
#define XB_XSUB(j)  (1280 + 64 * (j))
#define XB_XGEN(j)  (2304 + 64 * (j))
#define XB_TOP      3328
#define XB_TOPGEN   3392
#define XCD_BAR_WORDS 3456
#define XB_SPIN_CAP (1u << 18)

__device__ __forceinline__ unsigned xb_ld(unsigned* p)              { return __hip_atomic_load(p, __ATOMIC_RELAXED, __HIP_MEMORY_SCOPE_AGENT); }
__device__ __forceinline__ unsigned xb_add(unsigned* p, unsigned v) { return __hip_atomic_fetch_add(p, v, __ATOMIC_RELAXED, __HIP_MEMORY_SCOPE_AGENT); }
__device__ __forceinline__ unsigned xb_xcc_id() { return (unsigned)__builtin_amdgcn_s_getreg((3 << 11) | 20) & 0xFu; }
#define XB_SPIN(cond, bar) do { unsigned _sp = 0; while (cond) { __builtin_amdgcn_s_sleep(1); \
    if ((++_sp & 255u) == 0u) { if (xb_ld(&(bar)[XB_TMO])) break; if (_sp > XB_SPIN_CAP) { atomicAdd(&(bar)[XB_TMO], 1u); break; } } } } while (0)

struct XcdBarrier {
    unsigned* bar; unsigned x;
    volatile LAS unsigned* st;
};

__device__ __forceinline__ XcdBarrier xcd_barrier_post(unsigned* bar, volatile LAS unsigned* st) {
    XcdBarrier b; b.bar = bar; b.x = xb_xcc_id(); b.st = st;
    if (threadIdx.x == 0) (void)xb_add(&bar[XB_XCNT(b.x)], 1u);
    return b;
}
__device__ __forceinline__ void xcd_barrier_complete(unsigned* bar, unsigned x, unsigned& nloc, unsigned& nx) {
    const unsigned G = gridDim.x * gridDim.y * gridDim.z;
    unsigned sum, cnt, mine, sp = 0u;
    for (;;) {
        sum = 0u; cnt = 0u; mine = 0u;
#pragma unroll
        for (unsigned j = 0; j < 16; ++j) { const unsigned c = xb_ld(&bar[XB_XCNT(j)]); sum += c; cnt += (c > 0u) ? 1u : 0u; mine = (j == x) ? c : mine; }
        if (sum == G) break;
        __builtin_amdgcn_s_sleep(1);
        if ((++sp & 255u) == 0u) { if (xb_ld(&bar[XB_TMO])) break; if (sp > XB_SPIN_CAP) { atomicAdd(&bar[XB_TMO], 1u); break; } }
    }
    nloc = mine > 0u ? mine : 1u; nx = cnt > 0u ? cnt : 1u;
}

__device__ __forceinline__ void xcd_barrier(const XcdBarrier& b) {
    asm volatile("s_waitcnt vmcnt(0)" ::: "memory");
    __syncthreads();
    if (threadIdx.x == 0) {
        unsigned* bar = b.bar;
        __builtin_amdgcn_s_waitcnt(0);
        unsigned nloc = b.st[0], nx = b.st[1];
        if (nloc == 0u) { xcd_barrier_complete(bar, b.x, nloc, nx); b.st[0] = nloc; b.st[1] = nx; }
        const unsigned old = xb_add(&bar[XB_XSUB(b.x)], 1u);
        const unsigned gen = old / nloc;
        if (old + 1u == (gen + 1u) * nloc) {
            __builtin_amdgcn_fence(__ATOMIC_RELEASE, "agent");
            asm volatile("s_waitcnt vmcnt(0)" ::: "memory");
            const unsigned og = xb_add(&bar[XB_TOP], 1u);
            const unsigned tg = og / nx;
            if (og + 1u == (tg + 1u) * nx) xb_add(&bar[XB_TOPGEN], 1u);
            else XB_SPIN(xb_ld(&bar[XB_TOPGEN]) == tg, bar);
            __builtin_amdgcn_fence(__ATOMIC_ACQUIRE, "agent");
            xb_add(&bar[XB_XGEN(b.x)], 1u);
            asm volatile("s_waitcnt vmcnt(0)" ::: "memory");
        } else {
            XB_SPIN(xb_ld(&bar[XB_XGEN(b.x)]) == gen, bar);
            __builtin_amdgcn_fence(__ATOMIC_ACQUIRE, "agent");
            asm volatile("s_waitcnt vmcnt(0)" ::: "memory");
        }
    }
    __syncthreads();
}


__global__ void __launch_bounds__(512, 2) fwd_megakernel(Args A) {
    extern __shared__ __attribute__((aligned(16))) unsigned char lds_raw[];
    LAS unsigned char* lds = (LAS unsigned char*)lds_raw;
    cg::grid_group grid = cg::this_grid();
    { volatile LAS unsigned* m0 = (volatile LAS unsigned*)(lds + MISC_OFF); if (threadIdx.x < 16) m0[threadIdx.x] = 0u; }
    __syncthreads();
    const XcdBarrier xbar = xcd_barrier_post((unsigned*)(A.ws + WS_CTL) + 4096 + 4096 * A.pad, (volatile LAS unsigned*)(lds + MISC_OFF) + 8);
    const int tid = threadIdx.x, lane = tid & 63, wave = __builtin_amdgcn_readfirstlane(tid >> 6);
    const int G = gridDim.x;
    unsigned char* ws = A.ws;
    bf16_t* SEG0 = (bf16_t*)(ws + WS_SEG);
    float* PART1 = (float*)(ws + WS_PART1); float* PART2 = (float*)(ws + WS_PART2);

    if (A.mask & 1) { p0_prologue(A, lds, tid, lane, wave);
    xcd_barrier(xbar); }
    if (A.mask < 0) grid.sync();

    if (A.mask & 2) { pg8::Gemm g{(const bf16_t*)A.out, (const bf16_t*)(ws + WS_WIN), MTOT, INCOLS, DM}; pg8::StaticOrder S; S.init(MTOT, INCOLS, G, (int)blockIdx.x);
      EpiProj E{SEG0, (const float*)(ws + WS_COS), (const float*)(ws + WS_SIN)};
      pg8::gemm_phase<EpiProj, pg8::StaticOrder, true, true>(lds, g, S, E);
    xcd_barrier(xbar); }

    if (A.mask & 4) {
        const float lam = ((const float*)(ws + WS_CTL))[64];
        const unsigned xcd = ((unsigned)__builtin_amdgcn_s_getreg((3 << 11) | 20) & 0xFu) & 7u;
        volatile LAS int* misc = (volatile LAS int*)(lds + MISC_OFF);
        constexpr int NSCAN_X = NB * 8 / 8, NATT_X = NB * 8 * 32 / 8;
        for (;;) {
            if (tid == 0) {
                int q = misc[1], v = -1;
                while (q < 8) {
                    const int xq = (int)((xcd + (unsigned)q) & 7u);
                    const int it = (int)atomicAdd((unsigned*)(ws + WS_CTL) + 128 + 64 * xq + 1024 * A.pad, 1u);
                    if (it < NSCAN_X + NATT_X) { v = (xq << 16) | it; break; }
                    ++q;
                }
                misc[1] = q; misc[0] = v;
            }
            __syncthreads();
            const int v = misc[0];
            __syncthreads();
            if (v < 0) break;
            const int xq = v >> 16, it = v & 0xffff;
            if (it < NSCAN_X) { const int si = xq * NSCAN_X + it; scan_item(si >> 3, si & 7, A, lds); }
            else { const int a = it - NSCAN_X; const int qb = 31 - (a & 31), bh = xq * 16 + (a >> 5); attn_unit(bh >> 3, bh & 7, qb, A, lam, lds); }
        }
    xcd_barrier(xbar); }

    if (A.mask & 8) {
    { pg8::Gemm g{(const bf16_t*)A.out, (const bf16_t*)(ws + WS_WRNN), MREAL, DM, 2 * DM}; pg8::StaticOrder S; S.init(MREAL, DM, G, (int)blockIdx.x);
      EpiMerge E{SEG0, SEG0 + 5 * SEG_ELEMS, SEG0 + 6 * SEG_ELEMS};
      pg8::gemm_phase<EpiMerge, pg8::StaticOrder, true, true>(lds, g, S, E); }
    xcd_barrier(xbar); }

    if (A.mask & 16) { pg8::Gemm g{SEG0, (const bf16_t*)(ws + WS_WO), MREAL, DM, DM}; pg8::StaticOrder S; S.init(MREAL, DM, G, (int)blockIdx.x);
      EpiRes<true> E{A.in[0], nullptr, SEG0 + 6 * SEG_ELEMS, SEG0 + 1 * SEG_ELEMS, A.in[19], PART1};
      pg8::gemm_phase<EpiRes<true>, pg8::StaticOrder, true, true>(lds, g, S, E);
    xcd_barrier(xbar); }

    if (A.mask & 32) { pg8::Gemm g{SEG0 + 1 * SEG_ELEMS, (const bf16_t*)(ws + WS_W1), MREAL, DFF, DM}; pg8::StaticOrder S; S.init(MREAL, DFF, G, (int)blockIdx.x);
      EpiFF1 E{SEG0 + 2 * SEG_ELEMS, PART1};
      pg8::gemm_phase<EpiFF1, pg8::StaticOrder, true, true>(lds, g, S, E);
    xcd_barrier(xbar); }

    if (A.mask & 64) { pg8::Gemm g{SEG0 + 2 * SEG_ELEMS, (const bf16_t*)(ws + WS_W2), MREAL, DM, DFF}; pg8::StaticOrder S; S.init(MREAL, DM, G, (int)blockIdx.x);
      EpiRes<false> E{nullptr, SEG0 + 6 * SEG_ELEMS, SEG0, nullptr, nullptr, PART2};
      pg8::gemm_phase<EpiRes<false>, pg8::StaticOrder, true, true>(lds, g, S, E);
    xcd_barrier(xbar);

    {
        const int gw = blockIdx.x * 8 + wave, NGW = G * 8;
        const f32x4* gf = (const f32x4*)A.in[22] + lane;
        f32x4 gv[4];
#pragma unroll
        for (int j = 0; j < 4; ++j) gv[j] = gf[64 * j];
        for (int mrow = gw; mrow < MREAL; mrow += NGW) {
            const float pv = (lane < 16) ? PART2[(size_t)mrow * 16 + lane] : 0.f;
            const float rstd = 1.0f / sqrtf(wave_sum(pv) * (1.0f / DM) + EPS);
            f32x4* orow = (f32x4*)(A.out + (size_t)mrow * DM) + lane; const u32x2* hrow = (const u32x2*)(SEG0 + (size_t)mrow * DM) + lane;
#pragma unroll
            for (int j = 0; j < 4; ++j) { const u32x2 p = __builtin_nontemporal_load(hrow + 64 * j); const f32x4 v = (f32x4){bflo(p.x), bfhi(p.x), bflo(p.y), bfhi(p.y)}; __builtin_nontemporal_store(v * rstd * gv[j], orow + 64 * j); }
        }
    }
    }
}

#ifndef PHM_A
#define PHM_A 127
#endif
extern "C" void kernel_launch(void* const* d_in, const int* in_sizes, int n_in, void* d_out, int out_size, void* d_ws, size_t ws_size, hipStream_t stream) {
    static int grid = 0;
    if (grid == 0) {
        if (n_in != 23 || out_size != MREAL * DM || ws_size < WS_END) { fprintf(stderr, "kernel_launch: unexpected shapes: n_in %d out %d ws %zu (need %zu)\n", n_in, out_size, ws_size, (size_t)WS_END); grid = -1; return; }
        int dev = 0, cus = 0, per_cu = 0;
        hipGetDevice(&dev); hipDeviceGetAttribute(&cus, hipDeviceAttributeMultiprocessorCount, dev);
        hipFuncSetAttribute((const void*)fwd_megakernel, hipFuncAttributeMaxDynamicSharedMemorySize, LDS_BYTES);
        hipOccupancyMaxActiveBlocksPerMultiprocessor(&per_cu, (const void*)fwd_megakernel, 512, LDS_BYTES);
        if (per_cu < 1) per_cu = 1;
        (void)hipGetLastError();
        grid = cus * per_cu;
    }
    if (grid < 0) return;
    hipMemsetAsync((char*)d_ws + WS_CTL, 0, 65536, stream);
    Args a{};
    for (int i = 0; i < 23; ++i) a.in[i] = (const float*)d_in[i];
    a.out = (float*)d_out; a.ws = (unsigned char*)d_ws; a.mask = PHM_A; a.pad = 0;
    void* args[] = {&a};
    hipError_t e = hipLaunchCooperativeKernel((const void*)fwd_megakernel, dim3(grid), dim3(512), args, LDS_BYTES, stream);
#ifdef PHM_B
    a.mask = PHM_B; a.pad = 1;
    e = hipLaunchCooperativeKernel((const void*)fwd_megakernel, dim3(grid), dim3(512), args, LDS_BYTES, stream);
#endif
    if (e != hipSuccess) fprintf(stderr, "cooperative launch failed: %s (grid %d)\n", hipGetErrorString(e), grid);
}
```

```cpp
#include <hip/hip_runtime.h>
#include <hip/hip_cooperative_groups.h>
#include <cstdio>
#include <cstdint>
#include <cmath>
namespace cg = cooperative_groups;
namespace pg8 {
#define PG8_LAS __attribute__((address_space(3)))
typedef unsigned short bf16_t;
typedef short bf16x8 __attribute__((ext_vector_type(8)));
typedef float f32x4 __attribute__((ext_vector_type(4)));
typedef unsigned u32x4 __attribute__((ext_vector_type(4)));
constexpr int BM = 256, BK = 64, HALF = 128, HTB = HALF * BK * 2  , STAGE_BYTES = 8 * HTB, NXCD = 8, WGM = 8;

__host__ __device__ __forceinline__ int lds_byte(int r, int c) { const int st = (r >> 4) * 2 + (c >> 5), rr = r & 15, cc = c & 31, ob = rr * 64 + cc * 2; return st * 1024 + (ob ^ (((ob >> 9) & 1) << 5)); }
__host__ __device__ __forceinline__ void stage_rc(int b, int& R, int& C) { const int st = b / 1024, sb = b % 1024, swz = sb ^ (((sb >> 9) & 1) << 5); R = (st >> 1) * 16 + swz / 64; C = (st & 1) * 32 + (swz % 64) / 2; }
__host__ __device__ __forceinline__ int perm32(int rho) { const int n = rho >> 4, i = rho & 15; return 8 * (i >> 2) + 4 * n + (i & 3); }

struct Unit { int pm, pn; };
struct Gemm { const bf16_t* A; const bf16_t* Bt; int M, N, K; };

struct StaticOrder {
    int nM, nN, nwg, G, c;
    __host__ __device__ void init(int M, int N, int G_, int c_) { nM = M / BM; nN = N / BM; nwg = nM * nN; G = G_; c = c_; }
    __host__ __device__ bool next(int i, Unit& u) const {
        const long L = (long)i * G + c; if (L >= nwg) return false;
        int wgid = (int)L; { const int q = nwg / NXCD, r = nwg % NXCD, xcd = wgid % NXCD, off = wgid / NXCD; wgid = (xcd < r ? xcd * (q + 1) : r * (q + 1) + (xcd - r) * q) + off; }
        const int nig = WGM * nN, gid = wgid / nig, fm = gid * WGM, gsz = (nM - fm) < WGM ? (nM - fm) : WGM;
        u.pm = fm + ((wgid % nig) % gsz); u.pn = (wgid % nig) / gsz; return true;
    }
    __device__ __forceinline__ void a_ready(const Unit&) const {}
    __device__ __forceinline__ void done(const Unit&) const {}
};

__device__ __forceinline__ unsigned cvt_pk_bf16(float lo, float hi) { unsigned r; asm volatile("v_cvt_pk_bf16_f32 %0, %1, %2" : "=v"(r) : "v"(lo), "v"(hi)); return r; }
template <class Epi, class Sched, bool ALIGN_EPI = false, bool SP2 = false>
__device__ __forceinline__ void gemm_phase(PG8_LAS unsigned char* lds, const Gemm g, const Sched& S, const Epi& E) {
    const int tid = threadIdx.x, wid = __builtin_amdgcn_readfirstlane(tid >> 6), lane = tid & 63, wr = wid >> 2, wc = wid & 3, fr = lane & 15, fq = lane >> 4;
    const int K = g.K, nt = K / BK;
    unsigned voffA[2], voffB[2];
#pragma unroll
    for (int i = 0; i < 2; ++i) { int R, C; stage_rc(tid * 16 + i * 8192, R, C); const int Rb = Epi::PERM ? ((R & ~31) + perm32(R & 31)) : R;
        voffA[i] = (unsigned)(R * K + C) * 2u; voffB[i] = (unsigned)(Rb * K + C) * 2u; }
    const size_t kstep = (size_t)(BK * 2);
    const size_t hstep = (size_t)HALF * K * 2;
    const size_t tstep = 2 * hstep;
    const unsigned ldsw = (unsigned)wid * 1024u;
    const int aoff = lds_byte(wr * 64 + fr, fq * 8), boff = lds_byte(wc * 32 + fr, fq * 8);
#define PG8_SA(b, h) (((b) * 2 + (h)) * HTB)
#define PG8_SB(b, h) ((4 + (b) * 2 + (h)) * HTB)
#define PG8_STAGE(bufoff, gbase, voff) do { _Pragma("unroll") for (int _i = 0; _i < 2; ++_i) \
        __builtin_amdgcn_global_load_lds((const unsigned*)((const char*)(gbase) + (voff)[_i]), (PG8_LAS unsigned*)(lds + (bufoff) + ldsw + _i * 8192), 16, 0, 0); } while (0)
#define PG8_LDA(dst, b, h) do { _Pragma("unroll") for (int m = 0; m < 4; ++m) _Pragma("unroll") for (int k = 0; k < 2; ++k) dst[m][k] = *(const PG8_LAS bf16x8*)(lds + PG8_SA(b, h) + aoff + m * 2048 + k * 1024); } while (0)
#define PG8_LDB(dst, b, h) do { _Pragma("unroll") for (int n = 0; n < 2; ++n) _Pragma("unroll") for (int k = 0; k < 2; ++k) dst[n][k] = *(const PG8_LAS bf16x8*)(lds + PG8_SB(b, h) + boff + n * 2048 + k * 1024); } while (0)
#define PG8_MMA(ai, bj, At, Bt) do { __builtin_amdgcn_s_setprio(1); _Pragma("unroll") for (int m = 0; m < 4; ++m) _Pragma("unroll") for (int n = 0; n < 2; ++n) _Pragma("unroll") for (int k = 0; k < 2; ++k) \
        acc[ai][bj][m][n] = __builtin_amdgcn_mfma_f32_16x16x32_bf16(Bt[n][k], At[m][k], acc[ai][bj][m][n], 0, 0, 0); __builtin_amdgcn_s_setprio(0); } while (0)
#define PG8_WAIT_V(n) asm volatile("s_waitcnt vmcnt(" #n ")" ::: "memory")
#define PG8_WAIT_L(n) asm volatile("s_waitcnt lgkmcnt(" #n ")" ::: "memory")
#define PG8_BAR __builtin_amdgcn_s_barrier()
#define PG8_SCHED __builtin_amdgcn_sched_barrier(0)
    Unit cur, nxt; int ui = 0;
    if (!S.next(0, cur)) return;
    f32x4 acc[2][2][4][2];
#pragma unroll
    for (int a = 0; a < 2; ++a)
#pragma unroll
        for (int b = 0; b < 2; ++b)
#pragma unroll
            for (int m = 0; m < 4; ++m)
#pragma unroll
                for (int n = 0; n < 2; ++n) acc[a][b][m][n] = (f32x4){0.f, 0.f, 0.f, 0.f};
    bf16x8 At[4][2], B0[2][2], B1[2][2];
    const char* cA = (const char*)g.A + (size_t)cur.pm * tstep; const char* cB = (const char*)g.Bt + (size_t)cur.pn * tstep;
    S.a_ready(cur);
    if constexpr (SP2) {
        PG8_STAGE(PG8_SB(0, 0), cB, voffB); PG8_STAGE(PG8_SB(0, 1), cB + hstep, voffB); PG8_STAGE(PG8_SA(0, 0), cA, voffA); PG8_STAGE(PG8_SA(0, 1), cA + hstep, voffA);
        if (wr == 1) PG8_BAR;
        PG8_WAIT_V(2); PG8_BAR;
        PG8_STAGE(PG8_SB(1, 0), cB + kstep, voffB); PG8_STAGE(PG8_SA(1, 0), cA + kstep, voffA); PG8_STAGE(PG8_SB(1, 1), cB + hstep + kstep, voffB);
        PG8_WAIT_V(6); PG8_BAR;
    } else {
        PG8_STAGE(PG8_SB(0, 0), cB, voffB); PG8_STAGE(PG8_SA(0, 0), cA, voffA); PG8_STAGE(PG8_SB(0, 1), cB + hstep, voffB); PG8_STAGE(PG8_SA(0, 1), cA + hstep, voffA);
        if (wr == 1) PG8_BAR;
        PG8_WAIT_V(4); PG8_BAR;
        PG8_STAGE(PG8_SB(1, 0), cB + kstep, voffB); PG8_STAGE(PG8_SA(1, 0), cA + kstep, voffA); PG8_STAGE(PG8_SB(1, 1), cB + hstep + kstep, voffB);
        PG8_WAIT_V(6); PG8_BAR;
    }
    for (;;) {
        const bool has_next = S.next(ui + 1, nxt);
        const char* nA = has_next ? (const char*)g.A + (size_t)nxt.pm * tstep : cA; const char* nB = has_next ? (const char*)g.Bt + (size_t)nxt.pn * tstep : cB;
        for (int t = 0; t < nt; t += 2) {
            if constexpr (Epi::HAS_MID) { if (t == (nt >> 1)) E.mid(acc, cur, wr, wc, fr, fq); }
            const bool last = (t == nt - 2);
            const char* a1 = cA + (size_t)(t + 1) * kstep;
            const char* a2 = last ? nA : cA + (size_t)(t + 2) * kstep; const char* b2 = last ? nB : cB + (size_t)(t + 2) * kstep;
            const char* a3 = a2 + kstep; const char* b3 = b2 + kstep;
            if (last && has_next) S.a_ready(nxt);
            if constexpr (SP2) {
            PG8_LDB(B0, 0, 0); PG8_LDB(B1, 0, 1); PG8_SCHED; PG8_LDA(At, 0, 0); PG8_STAGE(PG8_SA(1, 1), a1 + hstep, voffA);
            PG8_WAIT_V(8); PG8_WAIT_L(0); PG8_BAR; PG8_MMA(0, 0, At, B0); PG8_MMA(0, 1, At, B1); PG8_BAR; PG8_SCHED;
            PG8_LDA(At, 0, 1); PG8_STAGE(PG8_SB(0, 0), b2, voffB); PG8_STAGE(PG8_SB(0, 1), b2 + hstep, voffB); PG8_STAGE(PG8_SA(0, 0), a2, voffA);
            PG8_WAIT_V(8); PG8_WAIT_L(0); PG8_BAR; PG8_MMA(1, 0, At, B0); PG8_MMA(1, 1, At, B1); PG8_BAR; PG8_SCHED;
            PG8_LDB(B0, 1, 0); PG8_LDB(B1, 1, 1); PG8_SCHED; PG8_LDA(At, 1, 0); PG8_STAGE(PG8_SA(0, 1), a2 + hstep, voffA);
            PG8_WAIT_V(8); PG8_WAIT_L(0); PG8_BAR; PG8_MMA(0, 0, At, B0); PG8_MMA(0, 1, At, B1); PG8_BAR; PG8_SCHED;
            PG8_LDA(At, 1, 1); PG8_STAGE(PG8_SB(1, 0), b3, voffB); PG8_STAGE(PG8_SB(1, 1), b3 + hstep, voffB); PG8_STAGE(PG8_SA(1, 0), a3, voffA);
            PG8_WAIT_V(8); PG8_WAIT_L(0); PG8_BAR; PG8_MMA(1, 0, At, B0); PG8_MMA(1, 1, At, B1); PG8_BAR; PG8_SCHED;
            } else {
            PG8_LDB(B0, 0, 0); PG8_SCHED; PG8_LDA(At, 0, 0); PG8_STAGE(PG8_SA(1, 1), a1 + hstep, voffA);
            PG8_WAIT_L(8); PG8_BAR; PG8_WAIT_L(0); PG8_MMA(0, 0, At, B0); PG8_BAR; PG8_SCHED;
            PG8_LDB(B1, 0, 1); PG8_STAGE(PG8_SB(0, 0), b2, voffB);
            PG8_BAR; PG8_WAIT_L(0); PG8_MMA(0, 1, At, B1); PG8_BAR;
            PG8_LDA(At, 0, 1); PG8_STAGE(PG8_SA(0, 0), a2, voffA);
            PG8_BAR; PG8_WAIT_L(0); PG8_MMA(1, 0, At, B0); PG8_BAR; PG8_SCHED;
            PG8_STAGE(PG8_SB(0, 1), b2 + hstep, voffB);
            PG8_WAIT_V(6); PG8_BAR; PG8_MMA(1, 1, At, B1); PG8_BAR;
            PG8_LDB(B0, 1, 0); PG8_SCHED; PG8_LDA(At, 1, 0); PG8_STAGE(PG8_SA(0, 1), a2 + hstep, voffA);
            PG8_WAIT_L(8); PG8_BAR; PG8_WAIT_L(0); PG8_MMA(0, 0, At, B0); PG8_BAR; PG8_SCHED;
            PG8_LDB(B1, 1, 1); PG8_STAGE(PG8_SB(1, 0), b3, voffB);
            PG8_BAR; PG8_WAIT_L(0); PG8_MMA(0, 1, At, B1); PG8_BAR;
            PG8_LDA(At, 1, 1); PG8_STAGE(PG8_SA(1, 0), a3, voffA);
            PG8_BAR; PG8_WAIT_L(0); PG8_MMA(1, 0, At, B0); PG8_BAR; PG8_SCHED;
            PG8_STAGE(PG8_SB(1, 1), b3 + hstep, voffB);
            PG8_WAIT_V(6); PG8_BAR; PG8_MMA(1, 1, At, B1); PG8_BAR;
            }
        }
        if constexpr (ALIGN_EPI) { if (wr == 0) PG8_BAR; }
        if constexpr (!Epi::AFTER_DRAIN) { E(acc, cur, wr, wc, fr, fq); S.done(cur); }
        if (!has_next) break;
#pragma unroll
        for (int a = 0; a < 2; ++a)
#pragma unroll
            for (int b = 0; b < 2; ++b)
#pragma unroll
                for (int m = 0; m < 4; ++m)
#pragma unroll
                    for (int n = 0; n < 2; ++n) acc[a][b][m][n] = (f32x4){0.f, 0.f, 0.f, 0.f};
        cur = nxt; cA = nA; cB = nB; ++ui;
        if constexpr (ALIGN_EPI) { if (wr == 1) PG8_BAR; }
    }
    PG8_WAIT_V(0);
    if constexpr (!ALIGN_EPI) { if (wr == 0) PG8_BAR; }
    PG8_BAR;
    if constexpr (Epi::AFTER_DRAIN) { E.fused(acc, cur, wr, wc, fr, fq, lds, wid, lane); S.done(cur); }
#undef PG8_SA
#undef PG8_SB
#undef PG8_STAGE
#undef PG8_LDA
#undef PG8_LDB
#undef PG8_MMA
#undef PG8_WAIT_V
#undef PG8_WAIT_L
#undef PG8_BAR
#undef PG8_SCHED
}
}
using pg8::bf16_t; using pg8::bf16x8; using pg8::f32x4; using pg8::u32x4; using pg8::Unit;
#define LAS __attribute__((address_space(3)))
typedef float f32x16 __attribute__((ext_vector_type(16)));
typedef unsigned u32x2 __attribute__((ext_vector_type(2)));
typedef short v4i16_t __attribute__((ext_vector_type(4)));

constexpr int NB = 16, SEQ = 4096, DM = 1024, NMETA = 16, MREAL = NB * SEQ  , MTOT = MREAL + 256  , NPOS = SEQ + NMETA  ;
constexpr int INCOLS = 7168, DFF = 4096;
constexpr float EPS = 1e-6f;
constexpr float C2 = 0.125f * 1.4426950408889634f;
constexpr size_t MiB = 1u << 20;
constexpr size_t WS_CTL = 0;
constexpr size_t WS_COS = 1 * MiB, WS_SIN = 2 * MiB;
constexpr size_t WS_PART1 = 3 * MiB, WS_PART2 = 7 * MiB;
constexpr size_t WS_WIN = 12 * MiB, WS_WRNN = 26 * MiB, WS_WATT = 28 * MiB, WS_WO = 30 * MiB, WS_W1 = 32 * MiB, WS_W2 = 40 * MiB, WS_WG = 48 * MiB;
constexpr size_t WS_SEG = 50 * MiB, SEG_BYTES = 129 * MiB, SEG_ELEMS = SEG_BYTES / 2;
constexpr size_t WS_END = WS_SEG + 7 * SEG_BYTES;
constexpr int LDS_BYTES = 147456, MISC_OFF = 131072 + 320;

__device__ const float INV_FREQ[32] = {1.000000000e+00f,7.498942018e-01f,5.623413324e-01f,4.216965139e-01f,3.162277639e-01f,2.371373922e-01f,1.778279394e-01f,1.333521456e-01f,1.000000015e-01f,7.498941571e-02f,5.623412877e-02f,4.216964915e-02f,3.162277862e-02f,2.371373586e-02f,1.778279431e-02f,1.333521493e-02f,9.999999776e-03f,7.498942316e-03f,5.623413250e-03f,4.216964822e-03f,3.162277862e-03f,2.371373819e-03f,1.778279431e-03f,1.333521446e-03f,1.000000047e-03f,7.498941850e-04f,5.623413017e-04f,4.216965463e-04f,3.162277862e-04f,2.371373848e-04f,1.778279402e-04f,1.333521504e-04f};

__device__ __forceinline__ unsigned f2bf(float f) { unsigned u = __builtin_bit_cast(unsigned, f); return (u + 0x7fffu + ((u >> 16) & 1u)) >> 16; }
typedef float f32x2_t __attribute__((ext_vector_type(2))); typedef __bf16 bf16x2_t __attribute__((ext_vector_type(2)));
__device__ __forceinline__ unsigned pk2(float lo, float hi) { f32x2_t v = {lo, hi}; bf16x2_t b = __builtin_convertvector(v, bf16x2_t); return __builtin_bit_cast(unsigned, b); }
__device__ __forceinline__ float bflo(unsigned w) { return __uint_as_float(w << 16); }
__device__ __forceinline__ float bfhi(unsigned w) { return __uint_as_float(w & 0xffff0000u); }
__device__ __forceinline__ float fsigmoid(float x) { return __builtin_amdgcn_rcpf(1.0f + __builtin_amdgcn_exp2f(-1.4426950408889634f * x)); }
__device__ __forceinline__ float gelu_tanh(float x) { const float z = 1.5957691216057308f * (x + 0.044715f * x * x * x); return x * fsigmoid(z); }
__device__ __forceinline__ float wave_sum(float v) {
#pragma unroll
    for (int o = 1; o < 64; o <<= 1) v += __shfl_xor(v, o);
    return v;
}
#define MEMFENCE() asm volatile("" ::: "memory")

struct EpiProj {
    static constexpr bool PERM = true, AFTER_DRAIN = false, HAS_MID = false;
    bf16_t* seg0; const float* cosT; const float* sinT;
    __device__ __forceinline__ void operator()(const f32x4 (&acc)[2][2][4][2], const Unit& u, int wr, int wc, int fr, int fq) const {
        const int seg = u.pn >> 2, colt = (u.pn & 3) * 256;
        bf16_t* base = seg0 + (size_t)seg * SEG_ELEMS;
        const int col0 = colt + wc * 32 + 8 * fq, row0 = u.pm * 256 + wr * 64 + fr;
        if (seg == 2 || seg == 3) {
            const float sc = (seg == 2) ? C2 : 1.0f;
            const int fi = 4 * (4 * (wc & 1) + fq);
#pragma unroll
            for (int ai = 0; ai < 2; ++ai)
#pragma unroll
                for (int m = 0; m < 4; ++m) {
                    const int row = row0 + ai * 128 + m * 16;
                    int pos = row < MREAL ? NMETA + (row & (SEQ - 1)) : row - MREAL; pos = pos < NPOS ? pos : NPOS - 1;
                    const f32x4 cs = *(const f32x4*)(cosT + pos * 32 + fi), sn = *(const f32x4*)(sinT + pos * 32 + fi);
                    bf16_t* rowp = base + (size_t)row * DM + col0;
#pragma unroll
                    for (int bj = 0; bj < 2; ++bj) {
                        const f32x4 v0 = acc[ai][bj][m][0], v1 = acc[ai][bj][m][1];
                        const f32x4 o0 = (v0 * cs - v1 * sn) * sc, o1 = (v1 * cs + v0 * sn) * sc;
                        u32x4 w; w.x = pk2(o0[0], o0[1]); w.y = pk2(o0[2], o0[3]); w.z = pk2(o1[0], o1[1]); w.w = pk2(o1[2], o1[3]);
                        *(u32x4*)(rowp + bj * 128) = w;
                    }
                    if (m & 1) MEMFENCE();
                }
        } else {
            const int mode = (seg == 1) ? 1 : (seg >= 5 ? 2 : 0);
#pragma unroll
            for (int ai = 0; ai < 2; ++ai)
#pragma unroll
                for (int m = 0; m < 4; ++m) {
                    const int row = row0 + ai * 128 + m * 16;
                    bf16_t* rowp = base + (size_t)row * DM + col0;
#pragma unroll
                    for (int bj = 0; bj < 2; ++bj) {
                        f32x4 v0 = acc[ai][bj][m][0], v1 = acc[ai][bj][m][1];
                        if (mode == 1) {
#pragma unroll
                            for (int i = 0; i < 4; ++i) { v0[i] = gelu_tanh(v0[i]); v1[i] = gelu_tanh(v1[i]); }
                        } else if (mode == 2) {
#pragma unroll
                            for (int i = 0; i < 4; ++i) { v0[i] = fsigmoid(v0[i]); v1[i] = fsigmoid(v1[i]); }
                        }
                        u32x4 w; w.x = pk2(v0[0], v0[1]); w.y = pk2(v0[2], v0[3]); w.z = pk2(v1[0], v1[1]); w.w = pk2(v1[2], v1[3]);
                        *(u32x4*)(rowp + bj * 128) = w;
                    }
                }
        }
    }
};
struct EpiMerge {
    static constexpr bool PERM = true, AFTER_DRAIN = false, HAS_MID = true;
    bf16_t* out; const bf16_t* gr; const bf16_t* ga;
    __device__ __forceinline__ void mid(f32x4 (&acc)[2][2][4][2], const Unit& u, int wr, int wc, int fr, int fq) const {
        int col0 = u.pn * 256 + wc * 32 + 8 * fq, row0 = u.pm * 256 + wr * 64 + fr;
        asm volatile("" : "+v"(col0), "+v"(row0));
#pragma unroll
        for (int ai = 0; ai < 2; ++ai)
#pragma unroll
            for (int m = 0; m < 4; ++m) {
                const size_t off = (size_t)(row0 + ai * 128 + m * 16) * DM + col0;
#pragma unroll
                for (int bj = 0; bj < 2; ++bj) {
                    const u32x4 r = *(const u32x4*)(gr + off + bj * 128), a = *(const u32x4*)(ga + off + bj * 128);
                    const unsigned rw[4] = {r.x, r.y, r.z, r.w}, aw[4] = {a.x, a.y, a.z, a.w};
#pragma unroll
                    for (int i = 0; i < 4; ++i) {
                        const float q0 = bflo(rw[i]) * __builtin_amdgcn_rcpf(fmaxf(bflo(aw[i]), 1e-30f)), q1 = bfhi(rw[i]) * __builtin_amdgcn_rcpf(fmaxf(bfhi(aw[i]), 1e-30f));
                        acc[ai][bj][m][i >> 1][2 * (i & 1)] *= q0; acc[ai][bj][m][i >> 1][2 * (i & 1) + 1] *= q1;
                    }
                }
                MEMFENCE();
            }
    }
    __device__ __forceinline__ void operator()(const f32x4 (&acc)[2][2][4][2], const Unit& u, int wr, int wc, int fr, int fq) const {
        const int col0 = u.pn * 256 + wc * 32 + 8 * fq, row0 = u.pm * 256 + wr * 64 + fr;
#pragma unroll
        for (int ai = 0; ai < 2; ++ai)
#pragma unroll
            for (int m = 0; m < 4; ++m) {
                const size_t off = (size_t)(row0 + ai * 128 + m * 16) * DM + col0;
#pragma unroll
                for (int bj = 0; bj < 2; ++bj) {
                    const u32x4 g = *(const u32x4*)(ga + off + bj * 128);
                    f32x4 v0 = acc[ai][bj][m][0], v1 = acc[ai][bj][m][1];
                    v0[0] *= bflo(g.x); v0[1] *= bfhi(g.x); v0[2] *= bflo(g.y); v0[3] *= bfhi(g.y);
                    v1[0] *= bflo(g.z); v1[1] *= bfhi(g.z); v1[2] *= bflo(g.w); v1[3] *= bfhi(g.w);
                    u32x4 w; w.x = pk2(v0[0], v0[1]); w.y = pk2(v0[2], v0[3]); w.z = pk2(v1[0], v1[1]); w.w = pk2(v1[2], v1[3]);
                    *(u32x4*)(out + off + bj * 128) = w;
                }
                MEMFENCE();
            }
    }
};
template <bool FIRST> struct EpiRes {
    static constexpr bool PERM = true, AFTER_DRAIN = false, HAS_MID = false;
    const float* basef; const bf16_t* baseh; bf16_t* out; bf16_t* hn; const float* g; float* part;
    __device__ __forceinline__ void operator()(const f32x4 (&acc)[2][2][4][2], const Unit& u, int wr, int wc, int fr, int fq) const {
        const int col0 = u.pn * 256 + wc * 32 + 8 * fq, row0 = u.pm * 256 + wr * 64 + fr;
#pragma unroll
        for (int ai = 0; ai < 2; ++ai)
#pragma unroll
            for (int m = 0; m < 4; ++m) {
                const int row = row0 + ai * 128 + m * 16; const size_t off = (size_t)row * DM + col0;
                float ss = 0.f;
#pragma unroll
                for (int bj = 0; bj < 2; ++bj) {
                    f32x4 h0, h1;
                    if (FIRST) { h0 = __builtin_nontemporal_load((const f32x4*)(basef + off + bj * 128)); h1 = __builtin_nontemporal_load((const f32x4*)(basef + off + bj * 128 + 4)); }
                    else { const u32x4 p = __builtin_nontemporal_load((const u32x4*)(baseh + off + bj * 128)); h0 = (f32x4){bflo(p.x), bfhi(p.x), bflo(p.y), bfhi(p.y)}; h1 = (f32x4){bflo(p.z), bfhi(p.z), bflo(p.w), bfhi(p.w)}; }
                    h0 += acc[ai][bj][m][0]; h1 += acc[ai][bj][m][1];
                    u32x4 w; w.x = pk2(h0[0], h0[1]); w.y = pk2(h0[2], h0[3]); w.z = pk2(h1[0], h1[1]); w.w = pk2(h1[2], h1[3]);
                    *(u32x4*)(out + off + bj * 128) = w;
                    ss += (h0[0] * h0[0] + h0[1] * h0[1]) + (h0[2] * h0[2] + h0[3] * h0[3]) + (h1[0] * h1[0] + h1[1] * h1[1]) + (h1[2] * h1[2] + h1[3] * h1[3]);
                    if (FIRST) {
                        const f32x4 g0 = *(const f32x4*)(g + col0 + bj * 128), g1 = *(const f32x4*)(g + col0 + bj * 128 + 4);
                        const f32x4 a = h0 * g0, b = h1 * g1;
                        u32x4 w2; w2.x = pk2(a[0], a[1]); w2.y = pk2(a[2], a[3]); w2.z = pk2(b[0], b[1]); w2.w = pk2(b[2], b[3]);
                        *(u32x4*)(hn + off + bj * 128) = w2;
                    }
                }
                ss += __shfl_xor(ss, 16); ss += __shfl_xor(ss, 32);
                if (fq == 0) part[(size_t)row * 16 + u.pn * 4 + wc] = ss;
                MEMFENCE();
            }
    }
};
struct EpiFF1 {
    static constexpr bool PERM = true, AFTER_DRAIN = false, HAS_MID = false;
    bf16_t* ff; const float* part;
    __device__ __forceinline__ void operator()(const f32x4 (&acc)[2][2][4][2], const Unit& u, int wr, int wc, int fr, int fq) const {
        const int col0 = u.pn * 256 + wc * 32 + 8 * fq, row0 = u.pm * 256 + wr * 64 + fr;
#pragma unroll
        for (int ai = 0; ai < 2; ++ai)
#pragma unroll
            for (int m = 0; m < 4; ++m) {
                const int row = row0 + ai * 128 + m * 16;
                const f32x4* pp = (const f32x4*)(part + (size_t)row * 16);
                const f32x4 p0 = pp[0], p1 = pp[1], p2 = pp[2], p3 = pp[3];
                const float s = ((p0[0] + p0[1]) + (p0[2] + p0[3])) + ((p1[0] + p1[1]) + (p1[2] + p1[3])) + ((p2[0] + p2[1]) + (p2[2] + p2[3])) + ((p3[0] + p3[1]) + (p3[2] + p3[3]));
                const float rstd = __builtin_amdgcn_rsqf(s * (1.0f / DM) + EPS);
                bf16_t* rowp = ff + (size_t)row * DFF + col0;
#pragma unroll
                for (int bj = 0; bj < 2; ++bj) {
                    f32x4 v0 = acc[ai][bj][m][0] * rstd, v1 = acc[ai][bj][m][1] * rstd;
#pragma unroll
                    for (int i = 0; i < 4; ++i) { v0[i] = fmaxf(v0[i], 0.f); v0[i] *= v0[i]; v1[i] = fmaxf(v1[i], 0.f); v1[i] *= v1[i]; }
                    u32x4 w; w.x = pk2(v0[0], v0[1]); w.y = pk2(v0[2], v0[3]); w.z = pk2(v1[0], v1[1]); w.w = pk2(v1[2], v1[3]);
                    __builtin_nontemporal_store(w, (u32x4*)(rowp + bj * 128));
                }
                if (m & 1) MEMFENCE();
            }
    }
};

struct Ctx {
    const float* in[23]; float* out; unsigned char* ws;
};
struct Args { const float* in[23]; float* out; unsigned char* ws; int mask; int pad; };

__device__ __forceinline__ void p0_transpose_item(const float* W, int K, int N, bf16_t* WT, int perm_lo, int perm_hi, LAS float* scr, int item, int lane, int ldk = 0) {
    if (ldk == 0) ldk = K;
    const int nblk = N / 32, kb = item / nblk, nb = item % nblk, k0 = 64 * kb, n0 = 32 * nb;
#pragma unroll 8
    for (int i = 0; i < 32; ++i) { const int kk = 2 * i + (lane >> 5); scr[kk * 33 + (lane & 31)] = W[(size_t)(k0 + kk) * N + n0 + (lane & 31)]; }
    asm volatile("s_waitcnt lgkmcnt(0)" ::: "memory");
    const int c = lane & 7;
#pragma unroll
    for (int j = 0; j < 4; ++j) { const int n = (lane >> 3) + 8 * j; const LAS float* s = scr + (8 * c) * 33 + n;
        u32x4 o; o.x = f2bf(s[0 * 33]) | (f2bf(s[1 * 33]) << 16); o.y = f2bf(s[2 * 33]) | (f2bf(s[3 * 33]) << 16); o.z = f2bf(s[4 * 33]) | (f2bf(s[5 * 33]) << 16); o.w = f2bf(s[6 * 33]) | (f2bf(s[7 * 33]) << 16);
        int nl = n0 + n;
        if (nl >= perm_lo && nl < perm_hi) { const int jj = nl & 63; const int gg = (jj < 32) ? (8 * (jj >> 2) + (jj & 3)) : (8 * ((jj - 32) >> 2) + 4 + (jj & 3)); nl = (nl & ~63) + gg; }
        *(u32x4*)(WT + (size_t)nl * ldk + k0 + 8 * c) = o; }
    asm volatile("s_waitcnt lgkmcnt(0)" ::: "memory");
}
__device__ __forceinline__ void rms_row_to_bf16(const float* xrow, const float* g, bf16_t* orow, int lane) {
    const f32x4* xr = (const f32x4*)xrow + lane; const f32x4* gr = (const f32x4*)g + lane;
    f32x4 v[4]; float s = 0.f;
#pragma unroll
    for (int j = 0; j < 4; ++j) { v[j] = __builtin_nontemporal_load(xr + 64 * j); s += (v[j][0] * v[j][0] + v[j][1] * v[j][1]) + (v[j][2] * v[j][2] + v[j][3] * v[j][3]); }
    const float rstd = 1.0f / sqrtf(wave_sum(s) * (1.0f / DM) + EPS);
    u32x2* o8 = (u32x2*)orow + lane;
#pragma unroll
    for (int j = 0; j < 4; ++j) { const f32x4 gg = gr[64 * j]; u32x2 w; w.x = pk2(v[j][0] * rstd * gg[0], v[j][1] * rstd * gg[1]); w.y = pk2(v[j][2] * rstd * gg[2], v[j][3] * rstd * gg[3]); o8[64 * j] = w; }
}
__device__ __forceinline__ void p0_prologue(const Args& A, LAS unsigned char* lds, int tid, int lane, int wave) {
    unsigned char* ws = A.ws;
    LAS float* scr = (LAS float*)(lds + wave * 16384);
    const int gw = blockIdx.x * 8 + wave, NGW = gridDim.x * 8;
    constexpr int I_IN = 16 * (INCOLS / 32), I_SQ = 16 * 32, I_1 = 16 * (DFF / 32), I_2 = (DFF / 64) * 32, I_G = 16 * 8;
    constexpr int NITEMS = I_IN + 3 * I_SQ + I_1 + I_2 + I_G;
    for (int it = gw; it < NITEMS; it += NGW) {
        int r = it;
        if (r < I_IN) { p0_transpose_item(A.in[3], DM, INCOLS, (bf16_t*)(ws + WS_WIN), 2048, 4096, scr, r, lane); continue; } r -= I_IN;
        if (r < I_SQ) { p0_transpose_item(A.in[16], DM, DM, (bf16_t*)(ws + WS_WRNN), 0, 0, scr, r, lane, 2 * DM); continue; } r -= I_SQ;
        if (r < I_SQ) { p0_transpose_item(A.in[17], DM, DM, (bf16_t*)(ws + WS_WRNN) + DM, 0, 0, scr, r, lane, 2 * DM); continue; } r -= I_SQ;
        if (r < I_SQ) { p0_transpose_item(A.in[18], DM, DM, (bf16_t*)(ws + WS_WO), 0, 0, scr, r, lane); continue; } r -= I_SQ;
        if (r < I_1) { p0_transpose_item(A.in[20], DM, DFF, (bf16_t*)(ws + WS_W1), 0, 0, scr, r, lane); continue; } r -= I_1;
        if (r < I_2) { p0_transpose_item(A.in[21], DFF, DM, (bf16_t*)(ws + WS_W2), 0, 0, scr, r, lane); continue; } r -= I_2;
        { const int blk = r >> 3, sub = r & 7;
          const int gate = blk >> 3, n = blk & 7;
          p0_transpose_item(A.in[gate ? 8 : 6] + (size_t)n * 128 * 128, 128, 128, (bf16_t*)(ws + WS_WG) + (size_t)(n * 2 + gate) * 128 * 128, 0, 0, scr, sub, lane); }
    }
    bf16_t* XN = (bf16_t*)A.out;
    for (int m = gw; m < MTOT; m += NGW) {
        if (m < MREAL) rms_row_to_bf16(A.in[0] + (size_t)m * DM, A.in[2], XN + (size_t)m * DM, lane);
        else if (m < MREAL + NMETA) rms_row_to_bf16(A.in[1] + (size_t)(m - MREAL) * DM, A.in[2], XN + (size_t)m * DM, lane);
        else { u32x2* o8 = (u32x2*)(XN + (size_t)m * DM) + lane;
#pragma unroll
            for (int j = 0; j < 4; ++j) o8[64 * j] = (u32x2){0u, 0u}; }
    }
    float* cosT = (float*)(ws + WS_COS); float* sinT = (float*)(ws + WS_SIN);
    for (int i = blockIdx.x * 512 + tid; i < NPOS * 32; i += gridDim.x * 512) {
        const int pos = i >> 5, fi = i & 31;
        const float ang = (float)pos * INV_FREQ[fi];
        double rev = (double)ang * 0.15915494309189535; rev -= __builtin_rint(rev);
        const float rf = (float)rev;
        cosT[i] = __builtin_amdgcn_cosf(rf); sinT[i] = __builtin_amdgcn_sinf(rf);
    }
    if (blockIdx.x == 0 && wave == 0) {
        const float a = A.in[11][lane] * A.in[12][lane], b = A.in[13][lane] * A.in[14][lane];
        const float sa = wave_sum(a), sb = wave_sum(b);
        if (lane == 0) ((float*)(ws + WS_CTL))[64] = __expf(sa) - __expf(sb) + 0.2f;
    }
}

__device__ __forceinline__ size_t seqrow(int b, int p) { return p < NMETA ? (size_t)(MREAL + p) : (size_t)b * SEQ + (size_t)(p - NMETA); }
__device__ __forceinline__ void scan_item(int b, int n, const Args& A, LAS unsigned char* lds) {
    const int tid = threadIdx.x, lane = tid & 63, w = __builtin_amdgcn_readfirstlane(tid >> 6), l15 = lane & 15, q4 = lane >> 4;
    constexpr int RP = 272;
    LAS unsigned char* XRt = lds;
    LAS unsigned char* GRt = lds + 18432;
    LAS unsigned char* At = lds + 18432 + 17408;
    LAS float* XCf = (LAS float*)(lds + 18432 + 2 * 17408);
    LAS float* CW = (LAS float*)(lds + 18432 + 2 * 17408 + 33792);
    unsigned char* ws = A.ws;
    const bf16_t* XR = (const bf16_t*)(ws + WS_SEG); const bf16_t* GR = (const bf16_t*)(ws + WS_SEG + SEG_BYTES); bf16_t* YR = (bf16_t*)A.out;
    for (int i = tid; i < 640; i += 512) { const int k = i >> 7, c = i & 127; CW[i] = k < 4 ? A.in[4][k * DM + n * 128 + c] : A.in[5][n * 128 + c]; }
    const int dl = 16 * w + l15, ch = n * 128 + dl;
    bf16x8 bw[2][4];
    { const bf16_t* WG = (const bf16_t*)(ws + WS_WG);
#pragma unroll
      for (int gate = 0; gate < 2; ++gate)
#pragma unroll
          for (int ks = 0; ks < 4; ++ks) bw[gate][ks] = *(const bf16x8*)(WG + ((size_t)(n * 2 + gate) * 128 + dl) * 128 + 32 * ks + 8 * q4); }
    const float ba = A.in[7][ch], bx = A.in[9][ch];
    float sp8;
    { const float e = __expf(-A.in[10][ch]);
      const float sp = (e < 0.05f) ? e * (1.0f + e * (-0.5f + e * (0.33333333f + e * (-0.25f + e * 0.2f)))) : 0.6931471805599453f * __builtin_amdgcn_logf(1.0f + e);
      sp8 = 8.0f * sp; }
    float hprev = 0.f;
    int rr0 = tid >> 4, c16 = tid & 15;
    asm volatile("" : "+v"(rr0), "+v"(c16));
    u32x4 xrg[3], grg[2];
    const u32x4 zero4 = (u32x4){0u, 0u, 0u, 0u};
#define SCAN_LOAD(i_) do { const int p0_ = NMETA + 64 * ((i_) - 1); \
        _Pragma("unroll") for (int j = 0; j < 3; ++j) { const int rr = rr0 + 32 * j; const int p = p0_ - 3 + rr; \
            xrg[j] = (rr < 67 && p >= 0) ? *(const u32x4*)(XR + seqrow(b, p) * DM + n * 128 + c16 * 8) : zero4; } \
        _Pragma("unroll") for (int j = 0; j < 2; ++j) { const int p = p0_ + rr0 + 32 * j; \
            grg[j] = (p >= 0) ? *(const u32x4*)(GR + seqrow(b, p) * DM + n * 128 + c16 * 8) : zero4; } } while (0)
    SCAN_LOAD(0);
    for (int i = 0; i <= 64; ++i) {
#pragma unroll
        for (int j = 0; j < 3; ++j) { const int rr = rr0 + 32 * j; if (rr < 67) *(LAS u32x4*)(XRt + rr * RP + c16 * 16) = xrg[j]; }
#pragma unroll
        for (int j = 0; j < 2; ++j) *(LAS u32x4*)(GRt + (rr0 + 32 * j) * RP + c16 * 16) = grg[j];
        __syncthreads();
        if (i < 64) SCAN_LOAD(i + 1);
#pragma unroll
        for (int j = 0; j < 2; ++j) {
            const int tt = rr0 + 32 * j;
            float a8[8];
            { const f32x4 b0 = *(const LAS f32x4*)(CW + 512 + 8 * c16), b1 = *(const LAS f32x4*)(CW + 512 + 8 * c16 + 4);
              a8[0] = b0[0]; a8[1] = b0[1]; a8[2] = b0[2]; a8[3] = b0[3]; a8[4] = b1[0]; a8[5] = b1[1]; a8[6] = b1[2]; a8[7] = b1[3]; }
#pragma unroll
            for (int k = 0; k < 4; ++k) {
                const u32x4 xv = *(const LAS u32x4*)(XRt + (tt + k) * RP + c16 * 16);
                const f32x4 w0 = *(const LAS f32x4*)(CW + k * 128 + 8 * c16), w1 = *(const LAS f32x4*)(CW + k * 128 + 8 * c16 + 4);
                a8[0] += w0[0] * bflo(xv.x); a8[1] += w0[1] * bfhi(xv.x); a8[2] += w0[2] * bflo(xv.y); a8[3] += w0[3] * bfhi(xv.y);
                a8[4] += w1[0] * bflo(xv.z); a8[5] += w1[1] * bfhi(xv.z); a8[6] += w1[2] * bflo(xv.w); a8[7] += w1[3] * bfhi(xv.w);
            }
            u32x4 pw; pw.x = pk2(a8[0], a8[1]); pw.y = pk2(a8[2], a8[3]); pw.z = pk2(a8[4], a8[5]); pw.w = pk2(a8[6], a8[7]);
            *(LAS u32x4*)(At + tt * RP + c16 * 16) = pw;
            *(LAS f32x4*)(XCf + tt * 132 + 8 * c16) = (f32x4){a8[0], a8[1], a8[2], a8[3]};
            *(LAS f32x4*)(XCf + tt * 132 + 8 * c16 + 4) = (f32x4){a8[4], a8[5], a8[6], a8[7]};
        }
        __syncthreads();
        f32x4 ar[4], ag[4];
#pragma unroll
        for (int mb = 0; mb < 4; ++mb) { ar[mb] = (f32x4){0.f, 0.f, 0.f, 0.f}; ag[mb] = (f32x4){0.f, 0.f, 0.f, 0.f};
#pragma unroll
            for (int ks = 0; ks < 4; ++ks) { const bf16x8 a = *(const LAS bf16x8*)(At + (16 * mb + l15) * RP + (32 * ks + 8 * q4) * 2);
                ar[mb] = __builtin_amdgcn_mfma_f32_16x16x32_bf16(a, bw[0][ks], ar[mb], 0, 0, 0);
                ag[mb] = __builtin_amdgcn_mfma_f32_16x16x32_bf16(a, bw[1][ks], ag[mb], 0, 0, 0); } }
#pragma unroll
        for (int mb = 0; mb < 4; ++mb) {
            float hl[4], cum[4];
#pragma unroll
            for (int j = 0; j < 4; ++j) {
                const int tl = 16 * mb + 4 * q4 + j;
                const float r = fsigmoid(ar[mb][j] + ba), ig = fsigmoid(ag[mb][j] + bx);
                const float la = -sp8 * r;
                float a = __builtin_amdgcn_exp2f(1.4426950408889634f * la);
                const float x2 = 2.0f * la;
                const float om = (x2 > -0.01f) ? -x2 * (1.0f + x2 * (0.5f + x2 * 0.16666667f)) : 1.0f - __builtin_amdgcn_exp2f(1.4426950408889634f * x2);
                float uu = __builtin_amdgcn_sqrtf(om) * ig * XCf[tl * 132 + dl];
                if (i == 0 && tl < 48) { uu = 0.f; a = 1.f; }
                if (j == 0) { hl[0] = uu; cum[0] = a; } else { hl[j] = a * hl[j - 1] + uu; cum[j] = cum[j - 1] * a; }
            }
            float P = cum[3], H = hl[3];
            { const float Pp = __shfl_up(P, 16), Hp = __shfl_up(H, 16); if (q4 >= 1) { H = P * Hp + H; P = P * Pp; } }
            { const float Pp = __shfl_up(P, 32), Hp = __shfl_up(H, 32); if (q4 >= 2) { H = P * Hp + H; P = P * Pp; } }
            const float Pe = __shfl_up(P, 16), He = __shfl_up(H, 16);
            const float hin = (q4 == 0) ? hprev : (Pe * hprev + He);
            const float Pl = __shfl(P, 48 + l15), Hl = __shfl(H, 48 + l15);
            hprev = Pl * hprev + Hl;
#pragma unroll
            for (int j = 0; j < 4; ++j) {
                const int tl = 16 * mb + 4 * q4 + j;
                const float h = hl[j] + cum[j] * hin;
                LAS unsigned short* gp = (LAS unsigned short*)(GRt + tl * RP) + dl;
                const float y = __uint_as_float(((unsigned)*gp) << 16) * h;
                *gp = (unsigned short)f2bf(y);
            }
        }
        __syncthreads();
        if (i >= 1) {
#pragma unroll
            for (int j = 0; j < 2; ++j) { const int rr = rr0 + 32 * j; const u32x4 v = *(const LAS u32x4*)(GRt + rr * RP + c16 * 16);
                *(u32x4*)(YR + ((size_t)b * SEQ + 64 * (i - 1) + rr) * (2 * DM) + n * 128 + c16 * 8) = v; }
        }
        __syncthreads();
    }
#undef SCAN_LOAD
}

__device__ __forceinline__ int crow(int r, int hi) { return (r & 3) + 8 * (r >> 2) + 4 * hi; }
constexpr int KP = 272, VP = 320, KB_BYTES = 64 * KP, VB_BYTES = 64 * VP, ABUF = KB_BYTES + VB_BYTES;
struct AttnSt {
    f32x16 o[4]; f32x16 negm; u32x4 pw[4]; float m, l; u32x4 kr[2], vr[2];
};
template <bool GEN> __device__ __forceinline__ void attn_step(AttnSt& st, const int t, const int NT, const int qb, LAS unsigned char* lds, const bf16x8 (&qf)[4],
                                                              const bf16_t* Kg, const bf16_t* Vg, const size_t brow, const int srow0, const int sc16,
                                                              const int koff, const int voff, const int qrel, const int hi) {
    const bool has_next = GEN ? (t + 1 < NT) : true, has_prev = GEN ? (t >= 1) : true;
    if (has_next) { const size_t rb = brow + 64 * t;
#pragma unroll
        for (int jj = 0; jj < 2; ++jj) st.kr[jj] = *(const u32x4*)(Kg + (rb + srow0 + 32 * jj) * DM); }
    { const size_t rb = (GEN && t == 0) ? (size_t)MREAL : brow + 64 * (t - 1);
#pragma unroll
        for (int jj = 0; jj < 2; ++jj) st.vr[jj] = *(const u32x4*)(Vg + (rb + srow0 + 32 * jj) * DM); }
#define VREAD(buf_, g_) do { _Pragma("unroll") for (int e = 0; e < 2; ++e) { \
        vlo[buf_][e] = __builtin_amdgcn_ds_read_tr16_b64_v4i16((LAS v4i16_t*)(vb + (16 * ((g_) >> 1)) * VP + (2 * ((g_) & 1) + e) * 64)); \
        vhi[buf_][e] = __builtin_amdgcn_ds_read_tr16_b64_v4i16((LAS v4i16_t*)(vb + (16 * ((g_) >> 1) + 8) * VP + (2 * ((g_) & 1) + e) * 64)); } } while (0)
    LAS unsigned char* vb = lds + 2 * KB_BYTES + ((t - 1) & 1) * VB_BYTES + voff;
    v4i16_t vlo[2][2], vhi[2][2];
    f32x16 n0, n1;
    const bool skipw = GEN && (t == NT - 1) && (threadIdx.x < 256);
    if (GEN && (skipw || t == 0)) {
#pragma unroll
        for (int r = 0; r < 16; ++r) { n0[r] = -INFINITY; n1[r] = -INFINITY; }
        if (!skipw) {
            LAS unsigned char* Kb = lds + (t & 1) * KB_BYTES + koff;
#pragma unroll
            for (int ks = 0; ks < 4; ++ks) { const bf16x8 a0 = *(const LAS bf16x8*)(Kb + 32 * ks);
                if (ks == 0) n0 = __builtin_amdgcn_mfma_f32_32x32x16_bf16(a0, qf[ks], st.negm, 0, 0, 0); else n0 = __builtin_amdgcn_mfma_f32_32x32x16_bf16(a0, qf[ks], n0, 0, 0, 0); }
        }
    } else {
        LAS unsigned char* Kb = lds + (t & 1) * KB_BYTES + koff;
#pragma unroll
        for (int ks = 0; ks < 4; ++ks) {
            const bf16x8 a0 = *(const LAS bf16x8*)(Kb + 32 * ks), a1 = *(const LAS bf16x8*)(Kb + 32 * KP + 32 * ks);
            if (ks == 0) { n0 = __builtin_amdgcn_mfma_f32_32x32x16_bf16(a0, qf[ks], st.negm, 0, 0, 0); n1 = __builtin_amdgcn_mfma_f32_32x32x16_bf16(a1, qf[ks], st.negm, 0, 0, 0); }
            else { n0 = __builtin_amdgcn_mfma_f32_32x32x16_bf16(a0, qf[ks], n0, 0, 0, 0); n1 = __builtin_amdgcn_mfma_f32_32x32x16_bf16(a1, qf[ks], n1, 0, 0, 0); }
        }
    }
    if (has_prev) VREAD(0, 0);
    if (GEN) {
        if (t == 0) {
#pragma unroll
            for (int r = 0; r < 16; ++r) { if (r >= 8) n0[r] = -INFINITY; n1[r] = -INFINITY; }
        } else if (t - 1 >= 2 * qb) {
            const int kb0 = 64 * (t - 1 - 2 * qb);
#pragma unroll
            for (int r = 0; r < 16; ++r) { const int kk = kb0 + crow(r, hi); if (kk > qrel) n0[r] = -INFINITY; if (kk + 32 > qrel) n1[r] = -INFINITY; }
        }
    }
    float rm;
    { float a = fmaxf(fmaxf(n0[0], n0[1]), n1[0]), b = fmaxf(fmaxf(n0[2], n0[3]), n1[1]); a = fmaxf(fmaxf(a, n1[2]), n1[3]);
#pragma unroll
      for (int r = 4; r < 16; r += 4) { a = fmaxf(fmaxf(a, n0[r]), n0[r + 1]); b = fmaxf(fmaxf(b, n0[r + 2]), n0[r + 3]); a = fmaxf(fmaxf(a, n1[r]), n1[r + 1]); b = fmaxf(fmaxf(b, n1[r + 2]), n1[r + 3]); }
      rm = fmaxf(a, b); }
    { const auto rr = __builtin_amdgcn_permlane32_swap(__float_as_uint(rm), __float_as_uint(rm), false, false); rm = fmaxf(__uint_as_float(rr[0]), __uint_as_float(rr[1])); }
    const bool grow = (GEN && t == 0) ? true : (rm > 8.0f);
    const bool any_grow = __any(grow);
    float alpha = 1.0f;
    if (any_grow) {
        const float dl = grow ? rm : 0.f;
        alpha = (GEN && t == 0) ? 0.f : __builtin_amdgcn_exp2f(-dl);
        st.m += dl;
#pragma unroll
        for (int r = 0; r < 16; ++r) { n0[r] -= dl; n1[r] -= dl; st.negm[r] = -st.m; }
    }
    float sa = 0.f, sb = 0.f;
    u32x4 npw[4];
#pragma unroll
    for (int g8 = 0; g8 < 8; ++g8) {
        const bool pv_on = has_prev && !(GEN && t == 1 && g8 >= 2);
        if (has_prev && g8 < 7 && !(GEN && t == 1 && g8 + 1 >= 2)) VREAD((g8 + 1) & 1, g8 + 1);
        __builtin_amdgcn_sched_barrier(0);
        if (pv_on) {
            const bf16x8 pf = __builtin_bit_cast(bf16x8, st.pw[g8 >> 1]);
#pragma unroll
            for (int e = 0; e < 2; ++e) {
                const v4i16_t lo = vlo[g8 & 1][e], hh = vhi[g8 & 1][e];
                const bf16x8 vf = (bf16x8){lo[0], lo[1], lo[2], lo[3], hh[0], hh[1], hh[2], hh[3]};
                st.o[2 * (g8 & 1) + e] = __builtin_amdgcn_mfma_f32_32x32x16_bf16(vf, pf, st.o[2 * (g8 & 1) + e], 0, 0, 0);
            }
        }
        if (GEN && (skipw || t == 0)) {
            const int r = 2 * g8;
            float x0 = 0.f, x1 = 0.f;
            if (!skipw && g8 < 4) { x0 = __builtin_amdgcn_exp2f(n0[r]); x1 = __builtin_amdgcn_exp2f(n0[r + 1]); }
            sa += x0; sb += x1;
            npw[g8 >> 2][g8 & 3] = pk2(x0, x1); npw[2 + (g8 >> 2)][g8 & 3] = 0u;
        } else {
            const int r = 2 * g8;
            const float x0 = __builtin_amdgcn_exp2f(n0[r]), x1 = __builtin_amdgcn_exp2f(n0[r + 1]);
            const float y0 = __builtin_amdgcn_exp2f(n1[r]), y1 = __builtin_amdgcn_exp2f(n1[r + 1]);
            sa += x0 + y0; sb += x1 + y1;
            npw[g8 >> 2][g8 & 3] = pk2(x0, x1); npw[2 + (g8 >> 2)][g8 & 3] = pk2(y0, y1);
        }
        __builtin_amdgcn_sched_barrier(0);
    }
#undef VREAD
    st.l = st.l * alpha + (sa + sb);
    if (any_grow) {
#pragma unroll
        for (int e = 0; e < 4; ++e)
#pragma unroll
            for (int r = 0; r < 16; ++r) st.o[e][r] *= alpha;
    }
#pragma unroll
    for (int k = 0; k < 4; ++k) st.pw[k] = npw[k];
    if (has_next) {
#pragma unroll
        for (int jj = 0; jj < 2; ++jj) *(LAS u32x4*)(lds + ((t + 1) & 1) * KB_BYTES + (srow0 + 32 * jj) * KP + sc16 * 16) = st.kr[jj]; }
#pragma unroll
    for (int jj = 0; jj < 2; ++jj) *(LAS u32x4*)(lds + 2 * KB_BYTES + (t & 1) * VB_BYTES + (srow0 + 32 * jj) * VP + sc16 * 16) = st.vr[jj];
    __syncthreads();
}
__device__ __forceinline__ void attn_unit(int b, int h, int qb, const Args& A, float lam, LAS unsigned char* lds) {
    const int tid = threadIdx.x, lane = tid & 63, wid = __builtin_amdgcn_readfirstlane(tid >> 6), c = wid & 1, g = wid >> 1, r32 = lane & 31, hi = lane >> 5;
    unsigned char* ws = A.ws;
    const bf16_t* Q = (const bf16_t*)(ws + WS_SEG + 2 * SEG_BYTES); const bf16_t* K = (const bf16_t*)(ws + WS_SEG + 3 * SEG_BYTES); const bf16_t* V = (const bf16_t*)(ws + WS_SEG + 4 * SEG_BYTES);
    const size_t rowq = (size_t)b * SEQ + qb * 128 + 32 * g + r32;
    bf16x8 qf[4];
#pragma unroll
    for (int ks = 0; ks < 4; ++ks) qf[ks] = *(const bf16x8*)(Q + rowq * DM + h * 128 + c * 64 + 16 * ks + 8 * hi);
    AttnSt st;
#pragma unroll
    for (int e = 0; e < 4; ++e)
#pragma unroll
        for (int r = 0; r < 16; ++r) st.o[e][r] = 0.f;
    st.m = 0.f; st.l = 0.f;
#pragma unroll
    for (int r = 0; r < 16; ++r) st.negm[r] = 0.f;
#pragma unroll
    for (int k = 0; k < 4; ++k) st.pw[k] = (u32x4){0u, 0u, 0u, 0u};
    const int NT = 2 * qb + 3;
    int srow0 = tid >> 4, sc16 = tid & 15;
    asm volatile("" : "+v"(srow0), "+v"(sc16));
    const bf16_t* Kg = K + h * 128 + sc16 * 8; const bf16_t* Vg = V + h * 128 + sc16 * 8;
    const size_t brow = (size_t)b * SEQ;
    const int koff = r32 * KP + 128 * c + 16 * hi;
    const int voff = (4 * hi + ((lane & 15) >> 2)) * VP + (16 * ((lane >> 4) & 1) + 4 * (lane & 3)) * 2;
    const int qrel = 32 * g + r32;
    {
#pragma unroll
        for (int jj = 0; jj < 2; ++jj) { const u32x4 k0 = *(const u32x4*)(Kg + ((size_t)MREAL + srow0 + 32 * jj) * DM); *(LAS u32x4*)(lds + (srow0 + 32 * jj) * KP + sc16 * 16) = k0; }
        __syncthreads();
    }
    int t = 0;
    attn_step<true>(st, 0, NT, qb, lds, qf, Kg, Vg, brow, srow0, sc16, koff, voff, qrel, hi);
    t = 1;
    if (NT > 3) { attn_step<true>(st, 1, NT, qb, lds, qf, Kg, Vg, brow, srow0, sc16, koff, voff, qrel, hi); t = 2; }
    for (; t + 2 < NT; ++t) attn_step<false>(st, t, NT, qb, lds, qf, Kg, Vg, brow, srow0, sc16, koff, voff, qrel, hi);
    for (; t < NT; ++t) attn_step<true>(st, t, NT, qb, lds, qf, Kg, Vg, brow, srow0, sc16, koff, voff, qrel, hi);
    if (wid >= 4) {
        LAS unsigned char* vb = lds + 2 * KB_BYTES + ((NT - 1) & 1) * VB_BYTES + voff;
#pragma unroll
        for (int s = 0; s < 4; ++s) {
            const bf16x8 pf = __builtin_bit_cast(bf16x8, st.pw[s]);
#pragma unroll
            for (int e = 0; e < 4; ++e) {
                const v4i16_t lo = __builtin_amdgcn_ds_read_tr16_b64_v4i16((LAS v4i16_t*)(vb + (16 * s) * VP + e * 64));
                const v4i16_t hh = __builtin_amdgcn_ds_read_tr16_b64_v4i16((LAS v4i16_t*)(vb + (16 * s + 8) * VP + e * 64));
                const bf16x8 vf = (bf16x8){lo[0], lo[1], lo[2], lo[3], hh[0], hh[1], hh[2], hh[3]};
                st.o[e] = __builtin_amdgcn_mfma_f32_32x32x16_bf16(vf, pf, st.o[e], 0, 0, 0);
            }
        }
    }
    __syncthreads();
    float l = st.l; l += __shfl_xor(l, 32);
    const float inv = 1.0f / l;
    LAS float* comb = (LAS float*)lds + g * 4096;
    if (c == 1) {
        const float sc = lam * inv;
#pragma unroll
        for (int e = 0; e < 4; ++e)
#pragma unroll
            for (int r = 0; r < 16; ++r) comb[(e * 16 + r) * 64 + lane] = st.o[e][r] * sc;
    }
    __syncthreads();
    if (c == 0) {
        float ss = 0.f;
#pragma unroll
        for (int e = 0; e < 4; ++e)
#pragma unroll
            for (int r = 0; r < 16; ++r) { const float d = st.o[e][r] * inv - comb[(e * 16 + r) * 64 + lane]; st.o[e][r] = d; ss += d * d; }
        ss += __shfl_xor(ss, 32);
        const float rms = __builtin_amdgcn_rsqf(ss * (1.0f / 128.0f) + EPS) * 0.8f;
        const float* gs = A.in[15];
        bf16_t* orow = (bf16_t*)A.out + rowq * (2 * DM) + DM + h * 128;
#pragma unroll
        for (int e = 0; e < 4; ++e)
#pragma unroll
            for (int rr = 0; rr < 4; ++rr) {
                const int e0 = 32 * e + 8 * rr + 4 * hi;
                const f32x4 gv = *(const f32x4*)(gs + e0);
                u32x2 w; w.x = pk2(st.o[e][4 * rr] * rms * gv[0], st.o[e][4 * rr + 1] * rms * gv[1]); w.y = pk2(st.o[e][4 * rr + 2] * rms * gv[2], st.o[e][4 * rr + 3] * rms * gv[3]);
                *(u32x2*)(orow + e0) = w;
            }
    }
    __syncthreads();
}

#define RLX_AGENT __ATOMIC_RELAXED, __HIP_MEMORY_SCOPE_AGENT
#define XB_TMO      128
#define XB_XCNT(j)  (256  + 64 * (j))
#define XB_XSUB(j)  (1280 + 64 * (j))
#define XB_XGEN(j)  (2304 + 64 * (j))
#define XB_TOP      3328
#define XB_TOPGEN   3392
#define XCD_BAR_WORDS 3456
#define XB_SPIN_CAP (1u << 18)

__device__ __forceinline__ unsigned xb_ld(unsigned* p)              { return __hip_atomic_load(p, __ATOMIC_RELAXED, __HIP_MEMORY_SCOPE_AGENT); }
__device__ __forceinline__ unsigned xb_add(unsigned* p, unsigned v) { return __hip_atomic_fetch_add(p, v, __ATOMIC_RELAXED, __HIP_MEMORY_SCOPE_AGENT); }
__device__ __forceinline__ unsigned xb_xcc_id() { return (unsigned)__builtin_amdgcn_s_getreg((3 << 11) | 20) & 0xFu; }
#define XB_SPIN(cond, bar) do { unsigned _sp = 0; while (cond) { __builtin_amdgcn_s_sleep(1); \
    if ((++_sp & 255u) == 0u) { if (xb_ld(&(bar)[XB_TMO])) break; if (_sp > XB_SPIN_CAP) { atomicAdd(&(bar)[XB_TMO], 1u); break; } } } } while (0)

struct XcdBarrier {
    unsigned* bar; unsigned x;
    volatile LAS unsigned* st;
};

__device__ __forceinline__ XcdBarrier xcd_barrier_post(unsigned* bar, volatile LAS unsigned* st) {
    XcdBarrier b; b.bar = bar; b.x = xb_xcc_id(); b.st = st;
    if (threadIdx.x == 0) (void)xb_add(&bar[XB_XCNT(b.x)], 1u);
    return b;
}
__device__ __forceinline__ void xcd_barrier_complete(unsigned* bar, unsigned x, unsigned& nloc, unsigned& nx) {
    const unsigned G = gridDim.x * gridDim.y * gridDim.z;
    unsigned sum, cnt, mine, sp = 0u;
    for (;;) {
        sum = 0u; cnt = 0u; mine = 0u;
#pragma unroll
        for (unsigned j = 0; j < 16; ++j) { const unsigned c = xb_ld(&bar[XB_XCNT(j)]); sum += c; cnt += (c > 0u) ? 1u : 0u; mine = (j == x) ? c : mine; }
        if (sum == G) break;
        __builtin_amdgcn_s_sleep(1);
        if ((++sp & 255u) == 0u) { if (xb_ld(&bar[XB_TMO])) break; if (sp > XB_SPIN_CAP) { atomicAdd(&bar[XB_TMO], 1u); break; } }
    }
    nloc = mine > 0u ? mine : 1u; nx = cnt > 0u ? cnt : 1u;
}

__device__ __forceinline__ void xcd_barrier(const XcdBarrier& b) {
    asm volatile("s_waitcnt vmcnt(0)" ::: "memory");
    __syncthreads();
    if (threadIdx.x == 0) {
        unsigned* bar = b.bar;
        __builtin_amdgcn_s_waitcnt(0);
        unsigned nloc = b.st[0], nx = b.st[1];
        if (nloc == 0u) { xcd_barrier_complete(bar, b.x, nloc, nx); b.st[0] = nloc; b.st[1] = nx; }
        const unsigned old = xb_add(&bar[XB_XSUB(b.x)], 1u);
        const unsigned gen = old / nloc;
        if (old + 1u == (gen + 1u) * nloc) {
            __builtin_amdgcn_fence(__ATOMIC_RELEASE, "agent");
            asm volatile("s_waitcnt vmcnt(0)" ::: "memory");
            const unsigned og = xb_add(&bar[XB_TOP], 1u);
            const unsigned tg = og / nx;
            if (og + 1u == (tg + 1u) * nx) xb_add(&bar[XB_TOPGEN], 1u);
            else XB_SPIN(xb_ld(&bar[XB_TOPGEN]) == tg, bar);
            __builtin_amdgcn_fence(__ATOMIC_ACQUIRE, "agent");
            xb_add(&bar[XB_XGEN(b.x)], 1u);
            asm volatile("s_waitcnt vmcnt(0)" ::: "memory");
        } else {
            XB_SPIN(xb_ld(&bar[XB_XGEN(b.x)]) == gen, bar);
            __builtin_amdgcn_fence(__ATOMIC_ACQUIRE, "agent");
            asm volatile("s_waitcnt vmcnt(0)" ::: "memory");
        }
    }
    __syncthreads();
}


__global__ void __launch_bounds__(512, 2) fwd_megakernel(Args A) {
    extern __shared__ __attribute__((aligned(16))) unsigned char lds_raw[];
    LAS unsigned char* lds = (LAS unsigned char*)lds_raw;
    cg::grid_group grid = cg::this_grid();
    { volatile LAS unsigned* m0 = (volatile LAS unsigned*)(lds + MISC_OFF); if (threadIdx.x < 16) m0[threadIdx.x] = 0u; }
    __syncthreads();
    const XcdBarrier xbar = xcd_barrier_post((unsigned*)(A.ws + WS_CTL) + 4096 + 4096 * A.pad, (volatile LAS unsigned*)(lds + MISC_OFF) + 8);
    const int tid = threadIdx.x, lane = tid & 63, wave = __builtin_amdgcn_readfirstlane(tid >> 6);
    const int G = gridDim.x;
    unsigned char* ws = A.ws;
    bf16_t* SEG0 = (bf16_t*)(ws + WS_SEG);
    float* PART1 = (float*)(ws + WS_PART1); float* PART2 = (float*)(ws + WS_PART2);

    if (A.mask & 1) { p0_prologue(A, lds, tid, lane, wave);
    xcd_barrier(xbar); }
    if (A.mask < 0) grid.sync();

    if (A.mask & 2) { pg8::Gemm g{(const bf16_t*)A.out, (const bf16_t*)(ws + WS_WIN), MTOT, INCOLS, DM}; pg8::StaticOrder S; S.init(MTOT, INCOLS, G, (int)blockIdx.x);
      EpiProj E{SEG0, (const float*)(ws + WS_COS), (const float*)(ws + WS_SIN)};
      pg8::gemm_phase<EpiProj, pg8::StaticOrder, true, true>(lds, g, S, E);
    xcd_barrier(xbar); }

    if (A.mask & 4) {
        const float lam = ((const float*)(ws + WS_CTL))[64];
        const unsigned xcd = ((unsigned)__builtin_amdgcn_s_getreg((3 << 11) | 20) & 0xFu) & 7u;
        volatile LAS int* misc = (volatile LAS int*)(lds + MISC_OFF);
        constexpr int NSCAN_X = NB * 8 / 8, NATT_X = NB * 8 * 32 / 8;
        for (;;) {
            if (tid == 0) {
                int q = misc[1], v = -1;
                while (q < 8) {
                    const int xq = (int)((xcd + (unsigned)q) & 7u);
                    const int it = (int)atomicAdd((unsigned*)(ws + WS_CTL) + 128 + 64 * xq + 1024 * A.pad, 1u);
                    if (it < NSCAN_X + NATT_X) { v = (xq << 16) | it; break; }
                    ++q;
                }
                misc[1] = q; misc[0] = v;
            }
            __syncthreads();
            const int v = misc[0];
            __syncthreads();
            if (v < 0) break;
            const int xq = v >> 16, it = v & 0xffff;
            if (it < NSCAN_X) { const int si = xq * NSCAN_X + it; scan_item(si >> 3, si & 7, A, lds); }
            else { const int a = it - NSCAN_X; const int qb = 31 - (a & 31), bh = xq * 16 + (a >> 5); attn_unit(bh >> 3, bh & 7, qb, A, lam, lds); }
        }
    xcd_barrier(xbar); }

    if (A.mask & 8) {
    { pg8::Gemm g{(const bf16_t*)A.out, (const bf16_t*)(ws + WS_WRNN), MREAL, DM, 2 * DM}; pg8::StaticOrder S; S.init(MREAL, DM, G, (int)blockIdx.x);
      EpiMerge E{SEG0, SEG0 + 5 * SEG_ELEMS, SEG0 + 6 * SEG_ELEMS};
      pg8::gemm_phase<EpiMerge, pg8::StaticOrder, true, true>(lds, g, S, E); }
    xcd_barrier(xbar); }

    if (A.mask & 16) { pg8::Gemm g{SEG0, (const bf16_t*)(ws + WS_WO), MREAL, DM, DM}; pg8::StaticOrder S; S.init(MREAL, DM, G, (int)blockIdx.x);
      EpiRes<true> E{A.in[0], nullptr, SEG0 + 6 * SEG_ELEMS, SEG0 + 1 * SEG_ELEMS, A.in[19], PART1};
      pg8::gemm_phase<EpiRes<true>, pg8::StaticOrder, true, true>(lds, g, S, E);
    xcd_barrier(xbar); }

    if (A.mask & 32) { pg8::Gemm g{SEG0 + 1 * SEG_ELEMS, (const bf16_t*)(ws + WS_W1), MREAL, DFF, DM}; pg8::StaticOrder S; S.init(MREAL, DFF, G, (int)blockIdx.x);
      EpiFF1 E{SEG0 + 2 * SEG_ELEMS, PART1};
      pg8::gemm_phase<EpiFF1, pg8::StaticOrder, true, true>(lds, g, S, E);
    xcd_barrier(xbar); }

    if (A.mask & 64) { pg8::Gemm g{SEG0 + 2 * SEG_ELEMS, (const bf16_t*)(ws + WS_W2), MREAL, DM, DFF}; pg8::StaticOrder S; S.init(MREAL, DM, G, (int)blockIdx.x);
      EpiRes<false> E{nullptr, SEG0 + 6 * SEG_ELEMS, SEG0, nullptr, nullptr, PART2};
      pg8::gemm_phase<EpiRes<false>, pg8::StaticOrder, true, true>(lds, g, S, E);
    xcd_barrier(xbar);

    {
        const int gw = blockIdx.x * 8 + wave, NGW = G * 8;
        const f32x4* gf = (const f32x4*)A.in[22] + lane;
        f32x4 gv[4];
#pragma unroll
        for (int j = 0; j < 4; ++j) gv[j] = gf[64 * j];
        for (int mrow = gw; mrow < MREAL; mrow += NGW) {
            const float pv = (lane < 16) ? PART2[(size_t)mrow * 16 + lane] : 0.f;
            const float rstd = 1.0f / sqrtf(wave_sum(pv) * (1.0f / DM) + EPS);
            f32x4* orow = (f32x4*)(A.out + (size_t)mrow * DM) + lane; const u32x2* hrow = (const u32x2*)(SEG0 + (size_t)mrow * DM) + lane;
#pragma unroll
            for (int j = 0; j < 4; ++j) { const u32x2 p = __builtin_nontemporal_load(hrow + 64 * j); const f32x4 v = (f32x4){bflo(p.x), bfhi(p.x), bflo(p.y), bfhi(p.y)}; __builtin_nontemporal_store(v * rstd * gv[j], orow + 64 * j); }
        }
    }
    }
}

#ifndef PHM_A
#define PHM_A 127
#endif
extern "C" void kernel_launch(void* const* d_in, const int* in_sizes, int n_in, void* d_out, int out_size, void* d_ws, size_t ws_size, hipStream_t stream) {
    static int grid = 0;
    if (grid == 0) {
        if (n_in != 23 || out_size != MREAL * DM || ws_size < WS_END) { fprintf(stderr, "kernel_launch: unexpected shapes: n_in %d out %d ws %zu (need %zu)\n", n_in, out_size, ws_size, (size_t)WS_END); grid = -1; return; }
        int dev = 0, cus = 0, per_cu = 0;
        hipGetDevice(&dev); hipDeviceGetAttribute(&cus, hipDeviceAttributeMultiprocessorCount, dev);
        hipFuncSetAttribute((const void*)fwd_megakernel, hipFuncAttributeMaxDynamicSharedMemorySize, LDS_BYTES);
        hipOccupancyMaxActiveBlocksPerMultiprocessor(&per_cu, (const void*)fwd_megakernel, 512, LDS_BYTES);
        if (per_cu < 1) per_cu = 1;
        (void)hipGetLastError();
        grid = cus * per_cu;
    }
    if (grid < 0) return;
    hipMemsetAsync((char*)d_ws + WS_CTL, 0, 65536, stream);
    Args a{};
    for (int i = 0; i < 23; ++i) a.in[i] = (const float*)d_in[i];
    a.out = (float*)d_out; a.ws = (unsigned char*)d_ws; a.mask = PHM_A; a.pad = 0;
    void* args[] = {&a};
    hipError_t e = hipLaunchCooperativeKernel((const void*)fwd_megakernel, dim3(grid), dim3(512), args, LDS_BYTES, stream);
#ifdef PHM_B
    a.mask = PHM_B; a.pad = 1;
    e = hipLaunchCooperativeKernel((const void*)fwd_megakernel, dim3(grid), dim3(512), args, LDS_BYTES, stream);
#endif
    if (e != hipSuccess) fprintf(stderr, "cooperative launch failed: %s (grid %d)\n", hipGetErrorString(e), grid);
}
```

```cpp
#include <hip/hip_runtime.h>
#include <hip/hip_cooperative_groups.h>
#include <cstdio>
#include <cstdint>
#include <cmath>
namespace cg = cooperative_groups;
namespace pg8 {
#define PG8_LAS __attribute__((address_space(3)))
typedef unsigned short bf16_t;
typedef short bf16x8 __attribute__((ext_vector_type(8)));
typedef float f32x4 __attribute__((ext_vector_type(4)));
typedef unsigned u32x4 __attribute__((ext_vector_type(4)));
constexpr int BM = 256, BK = 64, HALF = 128, HTB = HALF * BK * 2  , STAGE_BYTES = 8 * HTB, NXCD = 8, WGM = 8;

__host__ __device__ __forceinline__ int lds_byte(int r, int c) { const int st = (r >> 4) * 2 + (c >> 5), rr = r & 15, cc = c & 31, ob = rr * 64 + cc * 2; return st * 1024 + (ob ^ (((ob >> 9) & 1) << 5)); }
__host__ __device__ __forceinline__ void stage_rc(int b, int& R, int& C) { const int st = b / 1024, sb = b % 1024, swz = sb ^ (((sb >> 9) & 1) << 5); R = (st >> 1) * 16 + swz / 64; C = (st & 1) * 32 + (swz % 64) / 2; }
__host__ __device__ __forceinline__ int perm32(int rho) { const int n = rho >> 4, i = rho & 15; return 8 * (i >> 2) + 4 * n + (i & 3); }

struct Unit { int pm, pn; };
struct Gemm { const bf16_t* A; const bf16_t* Bt; int M, N, K; };

struct StaticOrder {
    int nM, nN, nwg, G, c;
    __host__ __device__ void init(int M, int N, int G_, int c_) { nM = M / BM; nN = N / BM; nwg = nM * nN; G = G_; c = c_; }
    __host__ __device__ bool next(int i, Unit& u) const {
        const long L = (long)i * G + c; if (L >= nwg) return false;
        int wgid = (int)L; { const int q = nwg / NXCD, r = nwg % NXCD, xcd = wgid % NXCD, off = wgid / NXCD; wgid = (xcd < r ? xcd * (q + 1) : r * (q + 1) + (xcd - r) * q) + off; }
        const int nig = WGM * nN, gid = wgid / nig, fm = gid * WGM, gsz = (nM - fm) < WGM ? (nM - fm) : WGM;
        u.pm = fm + ((wgid % nig) % gsz); u.pn = (wgid % nig) / gsz; return true;
    }
    __device__ __forceinline__ void a_ready(const Unit&) const {}
    __device__ __forceinline__ void done(const Unit&) const {}
};

__device__ __forceinline__ unsigned cvt_pk_bf16(float lo, float hi) { unsigned r; asm volatile("v_cvt_pk_bf16_f32 %0, %1, %2" : "=v"(r) : "v"(lo), "v"(hi)); return r; }
template <class Epi, class Sched, bool ALIGN_EPI = false, bool SP2 = false>
__device__ __forceinline__ void gemm_phase(PG8_LAS unsigned char* lds, const Gemm g, const Sched& S, const Epi& E) {
    const int tid = threadIdx.x, wid = __builtin_amdgcn_readfirstlane(tid >> 6), lane = tid & 63, wr = wid >> 2, wc = wid & 3, fr = lane & 15, fq = lane >> 4;
    const int K = g.K, nt = K / BK;
    unsigned voffA[2], voffB[2];
#pragma unroll
    for (int i = 0; i < 2; ++i) { int R, C; stage_rc(tid * 16 + i * 8192, R, C); const int Rb = Epi::PERM ? ((R & ~31) + perm32(R & 31)) : R;
        voffA[i] = (unsigned)(R * K + C) * 2u; voffB[i] = (unsigned)(Rb * K + C) * 2u; }
    const size_t kstep = (size_t)(BK * 2);
    const size_t hstep = (size_t)HALF * K * 2;
    const size_t tstep = 2 * hstep;
    const unsigned ldsw = (unsigned)wid * 1024u;
    const int aoff = lds_byte(wr * 64 + fr, fq * 8), boff = lds_byte(wc * 32 + fr, fq * 8);
#define PG8_SA(b, h) (((b) * 2 + (h)) * HTB)
#define PG8_SB(b, h) ((4 + (b) * 2 + (h)) * HTB)
#define PG8_STAGE(bufoff, gbase, voff) do { _Pragma("unroll") for (int _i = 0; _i < 2; ++_i) \
        __builtin_amdgcn_global_load_lds((const unsigned*)((const char*)(gbase) + (voff)[_i]), (PG8_LAS unsigned*)(lds + (bufoff) + ldsw + _i * 8192), 16, 0, 0); } while (0)
#define PG8_LDA(dst, b, h) do { _Pragma("unroll") for (int m = 0; m < 4; ++m) _Pragma("unroll") for (int k = 0; k < 2; ++k) dst[m][k] = *(const PG8_LAS bf16x8*)(lds + PG8_SA(b, h) + aoff + m * 2048 + k * 1024); } while (0)
#define PG8_LDB(dst, b, h) do { _Pragma("unroll") for (int n = 0; n < 2; ++n) _Pragma("unroll") for (int k = 0; k < 2; ++k) dst[n][k] = *(const PG8_LAS bf16x8*)(lds + PG8_SB(b, h) + boff + n * 2048 + k * 1024); } while (0)
#define PG8_MMA(ai, bj, At, Bt) do { __builtin_amdgcn_s_setprio(1); _Pragma("unroll") for (int m = 0; m < 4; ++m) _Pragma("unroll") for (int n = 0; n < 2; ++n) _Pragma("unroll") for (int k = 0; k < 2; ++k) \
        acc[ai][bj][m][n] = __builtin_amdgcn_mfma_f32_16x16x32_bf16(Bt[n][k], At[m][k], acc[ai][bj][m][n], 0, 0, 0); __builtin_amdgcn_s_setprio(0); } while (0)
#define PG8_WAIT_V(n) asm volatile("s_waitcnt vmcnt(" #n ")" ::: "memory")
#define PG8_WAIT_L(n) asm volatile("s_waitcnt lgkmcnt(" #n ")" ::: "memory")
#define PG8_BAR __builtin_amdgcn_s_barrier()
#define PG8_SCHED __builtin_amdgcn_sched_barrier(0)
    Unit cur, nxt; int ui = 0;
    if (!S.next(0, cur)) return;
    f32x4 acc[2][2][4][2];
#pragma unroll
    for (int a = 0; a < 2; ++a)
#pragma unroll
        for (int b = 0; b < 2; ++b)
#pragma unroll
            for (int m = 0; m < 4; ++m)
#pragma unroll
                for (int n = 0; n < 2; ++n) acc[a][b][m][n] = (f32x4){0.f, 0.f, 0.f, 0.f};
    bf16x8 At[4][2], B0[2][2], B1[2][2];
    const char* cA = (const char*)g.A + (size_t)cur.pm * tstep; const char* cB = (const char*)g.Bt + (size_t)cur.pn * tstep;
    S.a_ready(cur);
    if constexpr (SP2) {
        PG8_STAGE(PG8_SB(0, 0), cB, voffB); PG8_STAGE(PG8_SB(0, 1), cB + hstep, voffB); PG8_STAGE(PG8_SA(0, 0), cA, voffA); PG8_STAGE(PG8_SA(0, 1), cA + hstep, voffA);
        if (wr == 1) PG8_BAR;
        PG8_WAIT_V(2); PG8_BAR;
        PG8_STAGE(PG8_SB(1, 0), cB + kstep, voffB); PG8_STAGE(PG8_SA(1, 0), cA + kstep, voffA); PG8_STAGE(PG8_SB(1, 1), cB + hstep + kstep, voffB);
        PG8_WAIT_V(6); PG8_BAR;
    } else {
        PG8_STAGE(PG8_SB(0, 0), cB, voffB); PG8_STAGE(PG8_SA(0, 0), cA, voffA); PG8_STAGE(PG8_SB(0, 1), cB + hstep, voffB); PG8_STAGE(PG8_SA(0, 1), cA + hstep, voffA);
        if (wr == 1) PG8_BAR;
        PG8_WAIT_V(4); PG8_BAR;
        PG8_STAGE(PG8_SB(1, 0), cB + kstep, voffB); PG8_STAGE(PG8_SA(1, 0), cA + kstep, voffA); PG8_STAGE(PG8_SB(1, 1), cB + hstep + kstep, voffB);
        PG8_WAIT_V(6); PG8_BAR;
    }
    for (;;) {
        const bool has_next = S.next(ui + 1, nxt);
        const char* nA = has_next ? (const char*)g.A + (size_t)nxt.pm * tstep : cA; const char* nB = has_next ? (const char*)g.Bt + (size_t)nxt.pn * tstep : cB;
        for (int t = 0; t < nt; t += 2) {
            if constexpr (Epi::HAS_MID) { if (t == (nt >> 1)) E.mid(acc, cur, wr, wc, fr, fq); }
            const bool last = (t == nt - 2);
            const char* a1 = cA + (size_t)(t + 1) * kstep;
            const char* a2 = last ? nA : cA + (size_t)(t + 2) * kstep; const char* b2 = last ? nB : cB + (size_t)(t + 2) * kstep;
            const char* a3 = a2 + kstep; const char* b3 = b2 + kstep;
            if (last && has_next) S.a_ready(nxt);
            if constexpr (SP2) {
            PG8_LDB(B0, 0, 0); PG8_LDB(B1, 0, 1); PG8_SCHED; PG8_LDA(At, 0, 0); PG8_STAGE(PG8_SA(1, 1), a1 + hstep, voffA);
            PG8_WAIT_V(8); PG8_WAIT_L(0); PG8_BAR; PG8_MMA(0, 0, At, B0); PG8_MMA(0, 1, At, B1); PG8_BAR; PG8_SCHED;
            PG8_LDA(At, 0, 1); PG8_STAGE(PG8_SB(0, 0), b2, voffB); PG8_STAGE(PG8_SB(0, 1), b2 + hstep, voffB); PG8_STAGE(PG8_SA(0, 0), a2, voffA);
            PG8_WAIT_V(8); PG8_WAIT_L(0); PG8_BAR; PG8_MMA(1, 0, At, B0); PG8_MMA(1, 1, At, B1); PG8_BAR; PG8_SCHED;
            PG8_LDB(B0, 1, 0); PG8_LDB(B1, 1, 1); PG8_SCHED; PG8_LDA(At, 1, 0); PG8_STAGE(PG8_SA(0, 1), a2 + hstep, voffA);
            PG8_WAIT_V(8); PG8_WAIT_L(0); PG8_BAR; PG8_MMA(0, 0, At, B0); PG8_MMA(0, 1, At, B1); PG8_BAR; PG8_SCHED;
            PG8_LDA(At, 1, 1); PG8_STAGE(PG8_SB(1, 0), b3, voffB); PG8_STAGE(PG8_SB(1, 1), b3 + hstep, voffB); PG8_STAGE(PG8_SA(1, 0), a3, voffA);
            PG8_WAIT_V(8); PG8_WAIT_L(0); PG8_BAR; PG8_MMA(1, 0, At, B0); PG8_MMA(1, 1, At, B1); PG8_BAR; PG8_SCHED;
            } else {
            PG8_LDB(B0, 0, 0); PG8_SCHED; PG8_LDA(At, 0, 0); PG8_STAGE(PG8_SA(1, 1), a1 + hstep, voffA);
            PG8_WAIT_L(8); PG8_BAR; PG8_WAIT_L(0); PG8_MMA(0, 0, At, B0); PG8_BAR; PG8_SCHED;
            PG8_LDB(B1, 0, 1); PG8_STAGE(PG8_SB(0, 0), b2, voffB);
            PG8_BAR; PG8_WAIT_L(0); PG8_MMA(0, 1, At, B1); PG8_BAR;
            PG8_LDA(At, 0, 1); PG8_STAGE(PG8_SA(0, 0), a2, voffA);
            PG8_BAR; PG8_WAIT_L(0); PG8_MMA(1, 0, At, B0); PG8_BAR; PG8_SCHED;
            PG8_STAGE(PG8_SB(0, 1), b2 + hstep, voffB);
            PG8_WAIT_V(6); PG8_BAR; PG8_MMA(1, 1, At, B1); PG8_BAR;
            PG8_LDB(B0, 1, 0); PG8_SCHED; PG8_LDA(At, 1, 0); PG8_STAGE(PG8_SA(0, 1), a2 + hstep, voffA);
            PG8_WAIT_L(8); PG8_BAR; PG8_WAIT_L(0); PG8_MMA(0, 0, At, B0); PG8_BAR; PG8_SCHED;
            PG8_LDB(B1, 1, 1); PG8_STAGE(PG8_SB(1, 0), b3, voffB);
            PG8_BAR; PG8_WAIT_L(0); PG8_MMA(0, 1, At, B1); PG8_BAR;
            PG8_LDA(At, 1, 1); PG8_STAGE(PG8_SA(1, 0), a3, voffA);
            PG8_BAR; PG8_WAIT_L(0); PG8_MMA(1, 0, At, B0); PG8_BAR; PG8_SCHED;
            PG8_STAGE(PG8_SB(1, 1), b3 + hstep, voffB);
            PG8_WAIT_V(6); PG8_BAR; PG8_MMA(1, 1, At, B1); PG8_BAR;
            }
        }
        if constexpr (ALIGN_EPI) { if (wr == 0) PG8_BAR; }
        if constexpr (!Epi::AFTER_DRAIN) { E(acc, cur, wr, wc, fr, fq); S.done(cur); }
        if (!has_next) break;
#pragma unroll
        for (int a = 0; a < 2; ++a)
#pragma unroll
            for (int b = 0; b < 2; ++b)
#pragma unroll
                for (int m = 0; m < 4; ++m)
#pragma unroll
                    for (int n = 0; n < 2; ++n) acc[a][b][m][n] = (f32x4){0.f, 0.f, 0.f, 0.f};
        cur = nxt; cA = nA; cB = nB; ++ui;
        if constexpr (ALIGN_EPI) { if (wr == 1) PG8_BAR; }
    }
    PG8_WAIT_V(0);
    if constexpr (!ALIGN_EPI) { if (wr == 0) PG8_BAR; }
    PG8_BAR;
    if constexpr (Epi::AFTER_DRAIN) { E.fused(acc, cur, wr, wc, fr, fq, lds, wid, lane); S.done(cur); }
#undef PG8_SA
#undef PG8_SB
#undef PG8_STAGE
#undef PG8_LDA
#undef PG8_LDB
#undef PG8_MMA
#undef PG8_WAIT_V
#undef PG8_WAIT_L
#undef PG8_BAR
#undef PG8_SCHED
}
}
using pg8::bf16_t; using pg8::bf16x8; using pg8::f32x4; using pg8::u32x4; using pg8::Unit;
#define LAS __attribute__((address_space(3)))
typedef float f32x16 __attribute__((ext_vector_type(16)));
typedef unsigned u32x2 __attribute__((ext_vector_type(2)));
typedef short v4i16_t __attribute__((ext_vector_type(4)));

constexpr int NB = 16, SEQ = 4096, DM = 1024, NMETA = 16, MREAL = NB * SEQ  , MTOT = MREAL + 256  , NPOS = SEQ + NMETA  ;
constexpr int INCOLS = 7168, DFF = 4096;
constexpr float EPS = 1e-6f;
constexpr float C2 = 0.125f * 1.4426950408889634f;
constexpr size_t MiB = 1u << 20;
constexpr size_t WS_CTL = 0;
constexpr size_t WS_COS = 1 * MiB, WS_SIN = 2 * MiB;
constexpr size_t WS_PART1 = 3 * MiB, WS_PART2 = 7 * MiB;
constexpr size_t WS_WIN = 12 * MiB, WS_WRNN = 26 * MiB, WS_WATT = 28 * MiB, WS_WO = 30 * MiB, WS_W1 = 32 * MiB, WS_W2 = 40 * MiB, WS_WG = 48 * MiB;
constexpr size_t WS_SEG = 50 * MiB, SEG_BYTES = 129 * MiB, SEG_ELEMS = SEG_BYTES / 2;
constexpr size_t WS_END = WS_SEG + 7 * SEG_BYTES;
constexpr int LDS_BYTES = 147456, MISC_OFF = 131072 + 320;

__device__ const float INV_FREQ[32] = {1.000000000e+00f,7.498942018e-01f,5.623413324e-01f,4.216965139e-01f,3.162277639e-01f,2.371373922e-01f,1.778279394e-01f,1.333521456e-01f,1.000000015e-01f,7.498941571e-02f,5.623412877e-02f,4.216964915e-02f,3.162277862e-02f,2.371373586e-02f,1.778279431e-02f,1.333521493e-02f,9.999999776e-03f,7.498942316e-03f,5.623413250e-03f,4.216964822e-03f,3.162277862e-03f,2.371373819e-03f,1.778279431e-03f,1.333521446e-03f,1.000000047e-03f,7.498941850e-04f,5.623413017e-04f,4.216965463e-04f,3.162277862e-04f,2.371373848e-04f,1.778279402e-04f,1.333521504e-04f};

__device__ __forceinline__ unsigned f2bf(float f) { unsigned u = __builtin_bit_cast(unsigned, f); return (u + 0x7fffu + ((u >> 16) & 1u)) >> 16; }
typedef float f32x2_t __attribute__((ext_vector_type(2))); typedef __bf16 bf16x2_t __attribute__((ext_vector_type(2)));
__device__ __forceinline__ unsigned pk2(float lo, float hi) { f32x2_t v = {lo, hi}; bf16x2_t b = __builtin_convertvector(v, bf16x2_t); return __builtin_bit_cast(unsigned, b); }
__device__ __forceinline__ float bflo(unsigned w) { return __uint_as_float(w << 16); }
__device__ __forceinline__ float bfhi(unsigned w) { return __uint_as_float(w & 0xffff0000u); }
__device__ __forceinline__ float fsigmoid(float x) { return __builtin_amdgcn_rcpf(1.0f + __builtin_amdgcn_exp2f(-1.4426950408889634f * x)); }
__device__ __forceinline__ float gelu_tanh(float x) { const float z = 1.5957691216057308f * (x + 0.044715f * x * x * x); return x * fsigmoid(z); }
__device__ __forceinline__ float wave_sum(float v) {
#pragma unroll
    for (int o = 1; o < 64; o <<= 1) v += __shfl_xor(v, o);
    return v;
}
#define MEMFENCE() asm volatile("" ::: "memory")

struct EpiProj {
    static constexpr bool PERM = true, AFTER_DRAIN = false, HAS_MID = false;
    bf16_t* seg0; const float* cosT; const float* sinT;
    __device__ __forceinline__ void operator()(const f32x4 (&acc)[2][2][4][2], const Unit& u, int wr, int wc, int fr, int fq) const {
        const int seg = u.pn >> 2, colt = (u.pn & 3) * 256;
        bf16_t* base = seg0 + (size_t)seg * SEG_ELEMS;
        const int col0 = colt + wc * 32 + 8 * fq, row0 = u.pm * 256 + wr * 64 + fr;
        if (seg == 2 || seg == 3) {
            const float sc = (seg == 2) ? C2 : 1.0f;
            const int fi = 4 * (4 * (wc & 1) + fq);
#pragma unroll
            for (int ai = 0; ai < 2; ++ai)
#pragma unroll
                for (int m = 0; m < 4; ++m) {
                    const int row = row0 + ai * 128 + m * 16;
                    int pos = row < MREAL ? NMETA + (row & (SEQ - 1)) : row - MREAL; pos = pos < NPOS ? pos : NPOS - 1;
                    const f32x4 cs = *(const f32x4*)(cosT + pos * 32 + fi), sn = *(const f32x4*)(sinT + pos * 32 + fi);
                    bf16_t* rowp = base + (size_t)row * DM + col0;
#pragma unroll
                    for (int bj = 0; bj < 2; ++bj) {
                        const f32x4 v0 = acc[ai][bj][m][0], v1 = acc[ai][bj][m][1];
                        const f32x4 o0 = (v0 * cs - v1 * sn) * sc, o1 = (v1 * cs + v0 * sn) * sc;
                        u32x4 w; w.x = pk2(o0[0], o0[1]); w.y = pk2(o0[2], o0[3]); w.z = pk2(o1[0], o1[1]); w.w = pk2(o1[2], o1[3]);
                        *(u32x4*)(rowp + bj * 128) = w;
                    }
                    if (m & 1) MEMFENCE();
                }
        } else {
            const int mode = (seg == 1) ? 1 : (seg >= 5 ? 2 : 0);
#pragma unroll
            for (int ai = 0; ai < 2; ++ai)
#pragma unroll
                for (int m = 0; m < 4; ++m) {
                    const int row = row0 + ai * 128 + m * 16;
                    bf16_t* rowp = base + (size_t)row * DM + col0;
#pragma unroll
                    for (int bj = 0; bj < 2; ++bj) {
                        f32x4 v0 = acc[ai][bj][m][0], v1 = acc[ai][bj][m][1];
                        if (mode == 1) {
#pragma unroll
                            for (int i = 0; i < 4; ++i) { v0[i] = gelu_tanh(v0[i]); v1[i] = gelu_tanh(v1[i]); }
                        } else if (mode == 2) {
#pragma unroll
                            for (int i = 0; i < 4; ++i) { v0[i] = fsigmoid(v0[i]); v1[i] = fsigmoid(v1[i]); }
                        }
                        u32x4 w; w.x = pk2(v0[0], v0[1]); w.y = pk2(v0[2], v0[3]); w.z = pk2(v1[0], v1[1]); w.w = pk2(v1[2], v1[3]);
                        *(u32x4*)(rowp + bj * 128) = w;
                    }
                }
        }
    }
};
struct EpiMerge {
    static constexpr bool PERM = true, AFTER_DRAIN = false, HAS_MID = true;
    bf16_t* out; const bf16_t* gr; const bf16_t* ga;
    __device__ __forceinline__ void mid(f32x4 (&acc)[2][2][4][2], const Unit& u, int wr, int wc, int fr, int fq) const {
        int col0 = u.pn * 256 + wc * 32 + 8 * fq, row0 = u.pm * 256 + wr * 64 + fr;
        asm volatile("" : "+v"(col0), "+v"(row0));
#pragma unroll
        for (int ai = 0; ai < 2; ++ai)
#pragma unroll
            for (int m = 0; m < 4; ++m) {
                const size_t off = (size_t)(row0 + ai * 128 + m * 16) * DM + col0;
#pragma unroll
                for (int bj = 0; bj < 2; ++bj) {
                    const u32x4 r = *(const u32x4*)(gr + off + bj * 128), a = *(const u32x4*)(ga + off + bj * 128);
                    const unsigned rw[4] = {r.x, r.y, r.z, r.w}, aw[4] = {a.x, a.y, a.z, a.w};
#pragma unroll
                    for (int i = 0; i < 4; ++i) {
                        const float q0 = bflo(rw[i]) * __builtin_amdgcn_rcpf(fmaxf(bflo(aw[i]), 1e-30f)), q1 = bfhi(rw[i]) * __builtin_amdgcn_rcpf(fmaxf(bfhi(aw[i]), 1e-30f));
                        acc[ai][bj][m][i >> 1][2 * (i & 1)] *= q0; acc[ai][bj][m][i >> 1][2 * (i & 1) + 1] *= q1;
                    }
                }
                MEMFENCE();
            }
    }
    __device__ __forceinline__ void operator()(const f32x4 (&acc)[2][2][4][2], const Unit& u, int wr, int wc, int fr, int fq) const {
        const int col0 = u.pn * 256 + wc * 32 + 8 * fq, row0 = u.pm * 256 + wr * 64 + fr;
#pragma unroll
        for (int ai = 0; ai < 2; ++ai)
#pragma unroll
            for (int m = 0; m < 4; ++m) {
                const size_t off = (size_t)(row0 + ai * 128 + m * 16) * DM + col0;
#pragma unroll
                for (int bj = 0; bj < 2; ++bj) {
                    const u32x4 g = *(const u32x4*)(ga + off + bj * 128);
                    f32x4 v0 = acc[ai][bj][m][0], v1 = acc[ai][bj][m][1];
                    v0[0] *= bflo(g.x); v0[1] *= bfhi(g.x); v0[2] *= bflo(g.y); v0[3] *= bfhi(g.y);
                    v1[0] *= bflo(g.z); v1[1] *= bfhi(g.z); v1[2] *= bflo(g.w); v1[3] *= bfhi(g.w);
                    u32x4 w; w.x = pk2(v0[0], v0[1]); w.y = pk2(v0[2], v0[3]); w.z = pk2(v1[0], v1[1]); w.w = pk2(v1[2], v1[3]);
                    *(u32x4*)(out + off + bj * 128) = w;
                }
                MEMFENCE();
            }
    }
};
template <bool FIRST> struct EpiRes {
    static constexpr bool PERM = true, AFTER_DRAIN = false, HAS_MID = false;
    const float* basef; const bf16_t* baseh; bf16_t* out; bf16_t* hn; const float* g; float* part;
    __device__ __forceinline__ void operator()(const f32x4 (&acc)[2][2][4][2], const Unit& u, int wr, int wc, int fr, int fq) const {
        const int col0 = u.pn * 256 + wc * 32 + 8 * fq, row0 = u.pm * 256 + wr * 64 + fr;
#pragma unroll
        for (int ai = 0; ai < 2; ++ai)
#pragma unroll
            for (int m = 0; m < 4; ++m) {
                const int row = row0 + ai * 128 + m * 16; const size_t off = (size_t)row * DM + col0;
                float ss = 0.f;
#pragma unroll
                for (int bj = 0; bj < 2; ++bj) {
                    f32x4 h0, h1;
                    if (FIRST) { h0 = __builtin_nontemporal_load((const f32x4*)(basef + off + bj * 128)); h1 = __builtin_nontemporal_load((const f32x4*)(basef + off + bj * 128 + 4)); }
                    else { const u32x4 p = __builtin_nontemporal_load((const u32x4*)(baseh + off + bj * 128)); h0 = (f32x4){bflo(p.x), bfhi(p.x), bflo(p.y), bfhi(p.y)}; h1 = (f32x4){bflo(p.z), bfhi(p.z), bflo(p.w), bfhi(p.w)}; }
                    h0 += acc[ai][bj][m][0]; h1 += acc[ai][bj][m][1];
                    u32x4 w; w.x = pk2(h0[0], h0[1]); w.y = pk2(h0[2], h0[3]); w.z = pk2(h1[0], h1[1]); w.w = pk2(h1[2], h1[3]);
                    *(u32x4*)(out + off + bj * 128) = w;
                    ss += (h0[0] * h0[0] + h0[1] * h0[1]) + (h0[2] * h0[2] + h0[3] * h0[3]) + (h1[0] * h1[0] + h1[1] * h1[1]) + (h1[2] * h1[2] + h1[3] * h1[3]);
                    if (FIRST) {
                        const f32x4 g0 = *(const f32x4*)(g + col0 + bj * 128), g1 = *(const f32x4*)(g + col0 + bj * 128 + 4);
                        const f32x4 a = h0 * g0, b = h1 * g1;
                        u32x4 w2; w2.x = pk2(a[0], a[1]); w2.y = pk2(a[2], a[3]); w2.z = pk2(b[0], b[1]); w2.w = pk2(b[2], b[3]);
                        *(u32x4*)(hn + off + bj * 128) = w2;
                    }
                }
                ss += __shfl_xor(ss, 16); ss += __shfl_xor(ss, 32);
                if (fq == 0) part[(size_t)row * 16 + u.pn * 4 + wc] = ss;
                MEMFENCE();
            }
    }
};
struct EpiFF1 {
    static constexpr bool PERM = true, AFTER_DRAIN = false, HAS_MID = false;
    bf16_t* ff; const float* part;
    __device__ __forceinline__ void operator()(const f32x4 (&acc)[2][2][4][2], const Unit& u, int wr, int wc, int fr, int fq) const {
        const int col0 = u.pn * 256 + wc * 32 + 8 * fq, row0 = u.pm * 256 + wr * 64 + fr;
#pragma unroll
        for (int ai = 0; ai < 2; ++ai)
#pragma unroll
            for (int m = 0; m < 4; ++m) {
                const int row = row0 + ai * 128 + m * 16;
                const f32x4* pp = (const f32x4*)(part + (size_t)row * 16);
                const f32x4 p0 = pp[0], p1 = pp[1], p2 = pp[2], p3 = pp[3];
                const float s = ((p0[0] + p0[1]) + (p0[2] + p0[3])) + ((p1[0] + p1[1]) + (p1[2] + p1[3])) + ((p2[0] + p2[1]) + (p2[2] + p2[3])) + ((p3[0] + p3[1]) + (p3[2] + p3[3]));
                const float rstd = __builtin_amdgcn_rsqf(s * (1.0f / DM) + EPS);
                bf16_t* rowp = ff + (size_t)row * DFF + col0;
#pragma unroll
                for (int bj = 0; bj < 2; ++bj) {
                    f32x4 v0 = acc[ai][bj][m][0] * rstd, v1 = acc[ai][bj][m][1] * rstd;
#pragma unroll
                    for (int i = 0; i < 4; ++i) { v0[i] = fmaxf(v0[i], 0.f); v0[i] *= v0[i]; v1[i] = fmaxf(v1[i], 0.f); v1[i] *= v1[i]; }
                    u32x4 w; w.x = pk2(v0[0], v0[1]); w.y = pk2(v0[2], v0[3]); w.z = pk2(v1[0], v1[1]); w.w = pk2(v1[2], v1[3]);
                    __builtin_nontemporal_store(w, (u32x4*)(rowp + bj * 128));
                }
                if (m & 1) MEMFENCE();
            }
    }
};

struct Ctx {
    const float* in[23]; float* out; unsigned char* ws;
};
struct Args { const float* in[23]; float* out; unsigned char* ws; int mask; int pad; };

__device__ __forceinline__ void p0_transpose_item(const float* W, int K, int N, bf16_t* WT, int perm_lo, int perm_hi, LAS float* scr, int item, int lane, int ldk = 0) {
    if (ldk == 0) ldk = K;
    const int nblk = N / 32, kb = item / nblk, nb = item % nblk, k0 = 64 * kb, n0 = 32 * nb;
#pragma unroll 8
    for (int i = 0; i < 32; ++i) { const int kk = 2 * i + (lane >> 5); scr[kk * 33 + (lane & 31)] = W[(size_t)(k0 + kk) * N + n0 + (lane & 31)]; }
    asm volatile("s_waitcnt lgkmcnt(0)" ::: "memory");
    const int c = lane & 7;
#pragma unroll
    for (int j = 0; j < 4; ++j) { const int n = (lane >> 3) + 8 * j; const LAS float* s = scr + (8 * c) * 33 + n;
        u32x4 o; o.x = f2bf(s[0 * 33]) | (f2bf(s[1 * 33]) << 16); o.y = f2bf(s[2 * 33]) | (f2bf(s[3 * 33]) << 16); o.z = f2bf(s[4 * 33]) | (f2bf(s[5 * 33]) << 16); o.w = f2bf(s[6 * 33]) | (f2bf(s[7 * 33]) << 16);
        int nl = n0 + n;
        if (nl >= perm_lo && nl < perm_hi) { const int jj = nl & 63; const int gg = (jj < 32) ? (8 * (jj >> 2) + (jj & 3)) : (8 * ((jj - 32) >> 2) + 4 + (jj & 3)); nl = (nl & ~63) + gg; }
        *(u32x4*)(WT + (size_t)nl * ldk + k0 + 8 * c) = o; }
    asm volatile("s_waitcnt lgkmcnt(0)" ::: "memory");
}
__device__ __forceinline__ void rms_row_to_bf16(const float* xrow, const float* g, bf16_t* orow, int lane) {
    const f32x4* xr = (const f32x4*)xrow + lane; const f32x4* gr = (const f32x4*)g + lane;
    f32x4 v[4]; float s = 0.f;
#pragma unroll
    for (int j = 0; j < 4; ++j) { v[j] = __builtin_nontemporal_load(xr + 64 * j); s += (v[j][0] * v[j][0] + v[j][1] * v[j][1]) + (v[j][2] * v[j][2] + v[j][3] * v[j][3]); }
    const float rstd = 1.0f / sqrtf(wave_sum(s) * (1.0f / DM) + EPS);
    u32x2* o8 = (u32x2*)orow + lane;
#pragma unroll
    for (int j = 0; j < 4; ++j) { const f32x4 gg = gr[64 * j]; u32x2 w; w.x = pk2(v[j][0] * rstd * gg[0], v[j][1] * rstd * gg[1]); w.y = pk2(v[j][2] * rstd * gg[2], v[j][3] * rstd * gg[3]); o8[64 * j] = w; }
}
__device__ __forceinline__ void p0_prologue(const Args& A, LAS unsigned char* lds, int tid, int lane, int wave) {
    unsigned char* ws = A.ws;
    LAS float* scr = (LAS float*)(lds + wave * 16384);
    const int gw = blockIdx.x * 8 + wave, NGW = gridDim.x * 8;
    constexpr int I_IN = 16 * (INCOLS / 32), I_SQ = 16 * 32, I_1 = 16 * (DFF / 32), I_2 = (DFF / 64) * 32, I_G = 16 * 8;
    constexpr int NITEMS = I_IN + 3 * I_SQ + I_1 + I_2 + I_G;
    for (int it = gw; it < NITEMS; it += NGW) {
        int r = it;
        if (r < I_IN) { p0_transpose_item(A.in[3], DM, INCOLS, (bf16_t*)(ws + WS_WIN), 2048, 4096, scr, r, lane); continue; } r -= I_IN;
        if (r < I_SQ) { p0_transpose_item(A.in[16], DM, DM, (bf16_t*)(ws + WS_WRNN), 0, 0, scr, r, lane, 2 * DM); continue; } r -= I_SQ;
        if (r < I_SQ) { p0_transpose_item(A.in[17], DM, DM, (bf16_t*)(ws + WS_WRNN) + DM, 0, 0, scr, r, lane, 2 * DM); continue; } r -= I_SQ;
        if (r < I_SQ) { p0_transpose_item(A.in[18], DM, DM, (bf16_t*)(ws + WS_WO), 0, 0, scr, r, lane); continue; } r -= I_SQ;
        if (r < I_1) { p0_transpose_item(A.in[20], DM, DFF, (bf16_t*)(ws + WS_W1), 0, 0, scr, r, lane); continue; } r -= I_1;
        if (r < I_2) { p0_transpose_item(A.in[21], DFF, DM, (bf16_t*)(ws + WS_W2), 0, 0, scr, r, lane); continue; } r -= I_2;
        { const int blk = r >> 3, sub = r & 7;
          const int gate = blk >> 3, n = blk & 7;
          p0_transpose_item(A.in[gate ? 8 : 6] + (size_t)n * 128 * 128, 128, 128, (bf16_t*)(ws + WS_WG) + (size_t)(n * 2 + gate) * 128 * 128, 0, 0, scr, sub, lane); }
    }
    bf16_t* XN = (bf16_t*)A.out;
    for (int m = gw; m < MTOT; m += NGW) {
        if (m < MREAL) rms_row_to_bf16(A.in[0] + (size_t)m * DM, A.in[2], XN + (size_t)m * DM, lane);
        else if (m < MREAL + NMETA) rms_row_to_bf16(A.in[1] + (size_t)(m - MREAL) * DM, A.in[2], XN + (size_t)m * DM, lane);
        else { u32x2* o8 = (u32x2*)(XN + (size_t)m * DM) + lane;
#pragma unroll
            for (int j = 0; j < 4; ++j) o8[64 * j] = (u32x2){0u, 0u}; }
    }
    float* cosT = (float*)(ws + WS_COS); float* sinT = (float*)(ws + WS_SIN);
    for (int i = blockIdx.x * 512 + tid; i < NPOS * 32; i += gridDim.x * 512) {
        const int pos = i >> 5, fi = i & 31;
        const float ang = (float)pos * INV_FREQ[fi];
        double rev = (double)ang * 0.15915494309189535; rev -= __builtin_rint(rev);
        const float rf = (float)rev;
        cosT[i] = __builtin_amdgcn_cosf(rf); sinT[i] = __builtin_amdgcn_sinf(rf);
    }
    if (blockIdx.x == 0 && wave == 0) {
        const float a = A.in[11][lane] * A.in[12][lane], b = A.in[13][lane] * A.in[14][lane];
        const float sa = wave_sum(a), sb = wave_sum(b);
        if (lane == 0) ((float*)(ws + WS_CTL))[64] = __expf(sa) - __expf(sb) + 0.2f;
    }
}

__device__ __forceinline__ size_t seqrow(int b, int p) { return p < NMETA ? (size_t)(MREAL + p) : (size_t)b * SEQ + (size_t)(p - NMETA); }
__device__ __forceinline__ void scan_item(int b, int n, const Args& A, LAS unsigned char* lds) {
    const int tid = threadIdx.x, lane = tid & 63, w = __builtin_amdgcn_readfirstlane(tid >> 6), l15 = lane & 15, q4 = lane >> 4;
    constexpr int RP = 272;
    LAS unsigned char* XRt = lds;
    LAS unsigned char* GRt = lds + 18432;
    LAS unsigned char* At = lds + 18432 + 17408;
    LAS float* XCf = (LAS float*)(lds + 18432 + 2 * 17408);
    LAS float* CW = (LAS float*)(lds + 18432 + 2 * 17408 + 33792);
    unsigned char* ws = A.ws;
    const bf16_t* XR = (const bf16_t*)(ws + WS_SEG); const bf16_t* GR = (const bf16_t*)(ws + WS_SEG + SEG_BYTES); bf16_t* YR = (bf16_t*)A.out;
    for (int i = tid; i < 640; i += 512) { const int k = i >> 7, c = i & 127; CW[i] = k < 4 ? A.in[4][k * DM + n * 128 + c] : A.in[5][n * 128 + c]; }
    const int dl = 16 * w + l15, ch = n * 128 + dl;
    bf16x8 bw[2][4];
    { const bf16_t* WG = (const bf16_t*)(ws + WS_WG);
#pragma unroll
      for (int gate = 0; gate < 2; ++gate)
#pragma unroll
          for (int ks = 0; ks < 4; ++ks) bw[gate][ks] = *(const bf16x8*)(WG + ((size_t)(n * 2 + gate) * 128 + dl) * 128 + 32 * ks + 8 * q4); }
    const float ba = A.in[7][ch], bx = A.in[9][ch];
    float sp8;
    { const float e = __expf(-A.in[10][ch]);
      const float sp = (e < 0.05f) ? e * (1.0f + e * (-0.5f + e * (0.33333333f + e * (-0.25f + e * 0.2f)))) : 0.6931471805599453f * __builtin_amdgcn_logf(1.0f + e);
      sp8 = 8.0f * sp; }
    float hprev = 0.f;
    int rr0 = tid >> 4, c16 = tid & 15;
    asm volatile("" : "+v"(rr0), "+v"(c16));
    u32x4 xrg[3], grg[2];
    const u32x4 zero4 = (u32x4){0u, 0u, 0u, 0u};
#define SCAN_LOAD(i_) do { const int p0_ = NMETA + 64 * ((i_) - 1); \
        _Pragma("unroll") for (int j = 0; j < 3; ++j) { const int rr = rr0 + 32 * j; const int p = p0_ - 3 + rr; \
            xrg[j] = (rr < 67 && p >= 0) ? *(const u32x4*)(XR + seqrow(b, p) * DM + n * 128 + c16 * 8) : zero4; } \
        _Pragma("unroll") for (int j = 0; j < 2; ++j) { const int p = p0_ + rr0 + 32 * j; \
            grg[j] = (p >= 0) ? *(const u32x4*)(GR + seqrow(b, p) * DM + n * 128 + c16 * 8) : zero4; } } while (0)
    SCAN_LOAD(0);
    for (int i = 0; i <= 64; ++i) {
#pragma unroll
        for (int j = 0; j < 3; ++j) { const int rr = rr0 + 32 * j; if (rr < 67) *(LAS u32x4*)(XRt + rr * RP + c16 * 16) = xrg[j]; }
#pragma unroll
        for (int j = 0; j < 2; ++j) *(LAS u32x4*)(GRt + (rr0 + 32 * j) * RP + c16 * 16) = grg[j];
        __syncthreads();
        if (i < 64) SCAN_LOAD(i + 1);
#pragma unroll
        for (int j = 0; j < 2; ++j) {
            const int tt = rr0 + 32 * j;
            float a8[8];
            { const f32x4 b0 = *(const LAS f32x4*)(CW + 512 + 8 * c16), b1 = *(const LAS f32x4*)(CW + 512 + 8 * c16 + 4);
              a8[0] = b0[0]; a8[1] = b0[1]; a8[2] = b0[2]; a8[3] = b0[3]; a8[4] = b1[0]; a8[5] = b1[1]; a8[6] = b1[2]; a8[7] = b1[3]; }
#pragma unroll
            for (int k = 0; k < 4; ++k) {
                const u32x4 xv = *(const LAS u32x4*)(XRt + (tt + k) * RP + c16 * 16);
                const f32x4 w0 = *(const LAS f32x4*)(CW + k * 128 + 8 * c16), w1 = *(const LAS f32x4*)(CW + k * 128 + 8 * c16 + 4);
                a8[0] += w0[0] * bflo(xv.x); a8[1] += w0[1] * bfhi(xv.x); a8[2] += w0[2] * bflo(xv.y); a8[3] += w0[3] * bfhi(xv.y);
                a8[4] += w1[0] * bflo(xv.z); a8[5] += w1[1] * bfhi(xv.z); a8[6] += w1[2] * bflo(xv.w); a8[7] += w1[3] * bfhi(xv.w);
            }
            u32x4 pw; pw.x = pk2(a8[0], a8[1]); pw.y = pk2(a8[2], a8[3]); pw.z = pk2(a8[4], a8[5]); pw.w = pk2(a8[6], a8[7]);
            *(LAS u32x4*)(At + tt * RP + c16 * 16) = pw;
            *(LAS f32x4*)(XCf + tt * 132 + 8 * c16) = (f32x4){a8[0], a8[1], a8[2], a8[3]};
            *(LAS f32x4*)(XCf + tt * 132 + 8 * c16 + 4) = (f32x4){a8[4], a8[5], a8[6], a8[7]};
        }
        __syncthreads();
        f32x4 ar[4], ag[4];
#pragma unroll
        for (int mb = 0; mb < 4; ++mb) { ar[mb] = (f32x4){0.f, 0.f, 0.f, 0.f}; ag[mb] = (f32x4){0.f, 0.f, 0.f, 0.f};
#pragma unroll
            for (int ks = 0; ks < 4; ++ks) { const bf16x8 a = *(const LAS bf16x8*)(At + (16 * mb + l15) * RP + (32 * ks + 8 * q4) * 2);
                ar[mb] = __builtin_amdgcn_mfma_f32_16x16x32_bf16(a, bw[0][ks], ar[mb], 0, 0, 0);
                ag[mb] = __builtin_amdgcn_mfma_f32_16x16x32_bf16(a, bw[1][ks], ag[mb], 0, 0, 0); } }
#pragma unroll
        for (int mb = 0; mb < 4; ++mb) {
            float hl[4], cum[4];
#pragma unroll
            for (int j = 0; j < 4; ++j) {
                const int tl = 16 * mb + 4 * q4 + j;
                const float r = fsigmoid(ar[mb][j] + ba), ig = fsigmoid(ag[mb][j] + bx);
                const float la = -sp8 * r;
                float a = __builtin_amdgcn_exp2f(1.4426950408889634f * la);
                const float x2 = 2.0f * la;
                const float om = (x2 > -0.01f) ? -x2 * (1.0f + x2 * (0.5f + x2 * 0.16666667f)) : 1.0f - __builtin_amdgcn_exp2f(1.4426950408889634f * x2);
                float uu = __builtin_amdgcn_sqrtf(om) * ig * XCf[tl * 132 + dl];
                if (i == 0 && tl < 48) { uu = 0.f; a = 1.f; }
                if (j == 0) { hl[0] = uu; cum[0] = a; } else { hl[j] = a * hl[j - 1] + uu; cum[j] = cum[j - 1] * a; }
            }
            float P = cum[3], H = hl[3];
            { const float Pp = __shfl_up(P, 16), Hp = __shfl_up(H, 16); if (q4 >= 1) { H = P * Hp + H; P = P * Pp; } }
            { const float Pp = __shfl_up(P, 32), Hp = __shfl_up(H, 32); if (q4 >= 2) { H = P * Hp + H; P = P * Pp; } }
            const float Pe = __shfl_up(P, 16), He = __shfl_up(H, 16);
            const float hin = (q4 == 0) ? hprev : (Pe * hprev + He);
            const float Pl = __shfl(P, 48 + l15), Hl = __shfl(H, 48 + l15);
            hprev = Pl * hprev + Hl;
#pragma unroll
            for (int j = 0; j < 4; ++j) {
                const int tl = 16 * mb + 4 * q4 + j;
                const float h = hl[j] + cum[j] * hin;
                LAS unsigned short* gp = (LAS unsigned short*)(GRt + tl * RP) + dl;
                const float y = __uint_as_float(((unsigned)*gp) << 16) * h;
                *gp = (unsigned short)f2bf(y);
            }
        }
        __syncthreads();
        if (i >= 1) {
#pragma unroll
            for (int j = 0; j < 2; ++j) { const int rr = rr0 + 32 * j; const u32x4 v = *(const LAS u32x4*)(GRt + rr * RP + c16 * 16);
                *(u32x4*)(YR + ((size_t)b * SEQ + 64 * (i - 1) + rr) * (2 * DM) + n * 128 + c16 * 8) = v; }
        }
        __syncthreads();
    }
#undef SCAN_LOAD
}

__device__ __forceinline__ int crow(int r, int hi) { return (r & 3) + 8 * (r >> 2) + 4 * hi; }
constexpr int KP = 272, VP = 320, KB_BYTES = 64 * KP, VB_BYTES = 64 * VP, ABUF = KB_BYTES + VB_BYTES;
struct AttnSt {
    f32x16 o[4]; f32x16 negm; u32x4 pw[4]; float m, l; u32x4 kr[2], vr[2];
};
template <bool GEN> __device__ __forceinline__ void attn_step(AttnSt& st, const int t, const int NT, const int qb, LAS unsigned char* lds, const bf16x8 (&qf)[4],
                                                              const bf16_t* Kg, const bf16_t* Vg, const size_t brow, const int srow0, const int sc16,
                                                              const int koff, const int voff, const int qrel, const int hi) {
    const bool has_next = GEN ? (t + 1 < NT) : true, has_prev = GEN ? (t >= 1) : true;
    if (has_next) { const size_t rb = brow + 64 * t;
#pragma unroll
        for (int jj = 0; jj < 2; ++jj) st.kr[jj] = *(const u32x4*)(Kg + (rb + srow0 + 32 * jj) * DM); }
    { const size_t rb = (GEN && t == 0) ? (size_t)MREAL : brow + 64 * (t - 1);
#pragma unroll
        for (int jj = 0; jj < 2; ++jj) st.vr[jj] = *(const u32x4*)(Vg + (rb + srow0 + 32 * jj) * DM); }
#define VREAD(buf_, g_) do { _Pragma("unroll") for (int e = 0; e < 2; ++e) { \
        vlo[buf_][e] = __builtin_amdgcn_ds_read_tr16_b64_v4i16((LAS v4i16_t*)(vb + (16 * ((g_) >> 1)) * VP + (2 * ((g_) & 1) + e) * 64)); \
        vhi[buf_][e] = __builtin_amdgcn_ds_read_tr16_b64_v4i16((LAS v4i16_t*)(vb + (16 * ((g_) >> 1) + 8) * VP + (2 * ((g_) & 1) + e) * 64)); } } while (0)
    LAS unsigned char* vb = lds + 2 * KB_BYTES + ((t - 1) & 1) * VB_BYTES + voff;
    v4i16_t vlo[2][2], vhi[2][2];
    f32x16 n0, n1;
    {
        LAS unsigned char* Kb = lds + (t & 1) * KB_BYTES + koff;
#pragma unroll
        for (int ks = 0; ks < 4; ++ks) {
            const bf16x8 a0 = *(const LAS bf16x8*)(Kb + 32 * ks), a1 = *(const LAS bf16x8*)(Kb + 32 * KP + 32 * ks);
            if (ks == 0) { n0 = __builtin_amdgcn_mfma_f32_32x32x16_bf16(a0, qf[ks], st.negm, 0, 0, 0); n1 = __builtin_amdgcn_mfma_f32_32x32x16_bf16(a1, qf[ks], st.negm, 0, 0, 0); }
            else { n0 = __builtin_amdgcn_mfma_f32_32x32x16_bf16(a0, qf[ks], n0, 0, 0, 0); n1 = __builtin_amdgcn_mfma_f32_32x32x16_bf16(a1, qf[ks], n1, 0, 0, 0); }
        }
    }
    if (has_prev) VREAD(0, 0);
    if (GEN) {
        if (t == 0) {
#pragma unroll
            for (int r = 0; r < 16; ++r) { if (r >= 8) n0[r] = -INFINITY; n1[r] = -INFINITY; }
        } else if (t - 1 >= 2 * qb) {
            const int kb0 = 64 * (t - 1 - 2 * qb);
#pragma unroll
            for (int r = 0; r < 16; ++r) { const int kk = kb0 + crow(r, hi); if (kk > qrel) n0[r] = -INFINITY; if (kk + 32 > qrel) n1[r] = -INFINITY; }
        }
    }
    float rm;
    { float a = fmaxf(fmaxf(n0[0], n0[1]), n1[0]), b = fmaxf(fmaxf(n0[2], n0[3]), n1[1]); a = fmaxf(fmaxf(a, n1[2]), n1[3]);
#pragma unroll
      for (int r = 4; r < 16; r += 4) { a = fmaxf(fmaxf(a, n0[r]), n0[r + 1]); b = fmaxf(fmaxf(b, n0[r + 2]), n0[r + 3]); a = fmaxf(fmaxf(a, n1[r]), n1[r + 1]); b = fmaxf(fmaxf(b, n1[r + 2]), n1[r + 3]); }
      rm = fmaxf(a, b); }
    { const auto rr = __builtin_amdgcn_permlane32_swap(__float_as_uint(rm), __float_as_uint(rm), false, false); rm = fmaxf(__uint_as_float(rr[0]), __uint_as_float(rr[1])); }
    const bool grow = (GEN && t == 0) ? true : (rm > 8.0f);
    const bool any_grow = __any(grow);
    float alpha = 1.0f;
    if (any_grow) {
        const float dl = grow ? rm : 0.f;
        alpha = (GEN && t == 0) ? 0.f : __builtin_amdgcn_exp2f(-dl);
        st.m += dl;
#pragma unroll
        for (int r = 0; r < 16; ++r) { n0[r] -= dl; n1[r] -= dl; st.negm[r] = -st.m; }
    }
    float sa = 0.f, sb = 0.f;
    u32x4 npw[4];
#pragma unroll
    for (int g8 = 0; g8 < 8; ++g8) {
        if (has_prev && g8 < 7) VREAD((g8 + 1) & 1, g8 + 1);
        __builtin_amdgcn_sched_barrier(0);
        if (has_prev) {
            const bf16x8 pf = __builtin_bit_cast(bf16x8, st.pw[g8 >> 1]);
#pragma unroll
            for (int e = 0; e < 2; ++e) {
                const v4i16_t lo = vlo[g8 & 1][e], hh = vhi[g8 & 1][e];
                const bf16x8 vf = (bf16x8){lo[0], lo[1], lo[2], lo[3], hh[0], hh[1], hh[2], hh[3]};
                st.o[2 * (g8 & 1) + e] = __builtin_amdgcn_mfma_f32_32x32x16_bf16(vf, pf, st.o[2 * (g8 & 1) + e], 0, 0, 0);
            }
        }
        {
            const int r = 2 * g8;
            const float x0 = __builtin_amdgcn_exp2f(n0[r]), x1 = __builtin_amdgcn_exp2f(n0[r + 1]);
            const float y0 = __builtin_amdgcn_exp2f(n1[r]), y1 = __builtin_amdgcn_exp2f(n1[r + 1]);
            sa += x0 + y0; sb += x1 + y1;
            npw[g8 >> 2][g8 & 3] = pk2(x0, x1); npw[2 + (g8 >> 2)][g8 & 3] = pk2(y0, y1);
        }
        __builtin_amdgcn_sched_barrier(0);
    }
#undef VREAD
    st.l = st.l * alpha + (sa + sb);
    if (any_grow) {
#pragma unroll
        for (int e = 0; e < 4; ++e)
#pragma unroll
            for (int r = 0; r < 16; ++r) st.o[e][r] *= alpha;
    }
#pragma unroll
    for (int k = 0; k < 4; ++k) st.pw[k] = npw[k];
    if (has_next) {
#pragma unroll
        for (int jj = 0; jj < 2; ++jj) *(LAS u32x4*)(lds + ((t + 1) & 1) * KB_BYTES + (srow0 + 32 * jj) * KP + sc16 * 16) = st.kr[jj]; }
#pragma unroll
    for (int jj = 0; jj < 2; ++jj) *(LAS u32x4*)(lds + 2 * KB_BYTES + (t & 1) * VB_BYTES + (srow0 + 32 * jj) * VP + sc16 * 16) = st.vr[jj];
    __syncthreads();
}
__device__ __forceinline__ void attn_unit(int b, int h, int qb, const Args& A, float lam, LAS unsigned char* lds) {
    const int tid = threadIdx.x, lane = tid & 63, wid = __builtin_amdgcn_readfirstlane(tid >> 6), c = wid & 1, g = wid >> 1, r32 = lane & 31, hi = lane >> 5;
    unsigned char* ws = A.ws;
    const bf16_t* Q = (const bf16_t*)(ws + WS_SEG + 2 * SEG_BYTES); const bf16_t* K = (const bf16_t*)(ws + WS_SEG + 3 * SEG_BYTES); const bf16_t* V = (const bf16_t*)(ws + WS_SEG + 4 * SEG_BYTES);
    const size_t rowq = (size_t)b * SEQ + qb * 128 + 32 * g + r32;
    bf16x8 qf[4];
#pragma unroll
    for (int ks = 0; ks < 4; ++ks) qf[ks] = *(const bf16x8*)(Q + rowq * DM + h * 128 + c * 64 + 16 * ks + 8 * hi);
    AttnSt st;
#pragma unroll
    for (int e = 0; e < 4; ++e)
#pragma unroll
        for (int r = 0; r < 16; ++r) st.o[e][r] = 0.f;
    st.m = 0.f; st.l = 0.f;
#pragma unroll
    for (int r = 0; r < 16; ++r) st.negm[r] = 0.f;
#pragma unroll
    for (int k = 0; k < 4; ++k) st.pw[k] = (u32x4){0u, 0u, 0u, 0u};
    const int NT = 2 * qb + 3;
    int srow0 = tid >> 4, sc16 = tid & 15;
    asm volatile("" : "+v"(srow0), "+v"(sc16));
    const bf16_t* Kg = K + h * 128 + sc16 * 8; const bf16_t* Vg = V + h * 128 + sc16 * 8;
    const size_t brow = (size_t)b * SEQ;
    const int koff = r32 * KP + 128 * c + 16 * hi;
    const int voff = (4 * hi + ((lane & 15) >> 2)) * VP + (16 * ((lane >> 4) & 1) + 4 * (lane & 3)) * 2;
    const int qrel = 32 * g + r32;
    {
#pragma unroll
        for (int jj = 0; jj < 2; ++jj) { const u32x4 k0 = *(const u32x4*)(Kg + ((size_t)MREAL + srow0 + 32 * jj) * DM); *(LAS u32x4*)(lds + (srow0 + 32 * jj) * KP + sc16 * 16) = k0; }
        __syncthreads();
    }
    int t = 0;
    attn_step<true>(st, 0, NT, qb, lds, qf, Kg, Vg, brow, srow0, sc16, koff, voff, qrel, hi);
    for (t = 1; t + 2 < NT; ++t) attn_step<false>(st, t, NT, qb, lds, qf, Kg, Vg, brow, srow0, sc16, koff, voff, qrel, hi);
    for (; t < NT; ++t) attn_step<true>(st, t, NT, qb, lds, qf, Kg, Vg, brow, srow0, sc16, koff, voff, qrel, hi);
    {
        LAS unsigned char* vb = lds + 2 * KB_BYTES + ((NT - 1) & 1) * VB_BYTES + voff;
#pragma unroll
        for (int s = 0; s < 4; ++s) {
            const bf16x8 pf = __builtin_bit_cast(bf16x8, st.pw[s]);
#pragma unroll
            for (int e = 0; e < 4; ++e) {
                const v4i16_t lo = __builtin_amdgcn_ds_read_tr16_b64_v4i16((LAS v4i16_t*)(vb + (16 * s) * VP + e * 64));
                const v4i16_t hh = __builtin_amdgcn_ds_read_tr16_b64_v4i16((LAS v4i16_t*)(vb + (16 * s + 8) * VP + e * 64));
                const bf16x8 vf = (bf16x8){lo[0], lo[1], lo[2], lo[3], hh[0], hh[1], hh[2], hh[3]};
                st.o[e] = __builtin_amdgcn_mfma_f32_32x32x16_bf16(vf, pf, st.o[e], 0, 0, 0);
            }
        }
    }
    __syncthreads();
    float l = st.l; l += __shfl_xor(l, 32);
    const float inv = 1.0f / l;
    LAS float* comb = (LAS float*)lds + g * 4096;
    if (c == 1) {
        const float sc = lam * inv;
#pragma unroll
        for (int e = 0; e < 4; ++e)
#pragma unroll
            for (int r = 0; r < 16; ++r) comb[(e * 16 + r) * 64 + lane] = st.o[e][r] * sc;
    }
    __syncthreads();
    if (c == 0) {
        float ss = 0.f;
#pragma unroll
        for (int e = 0; e < 4; ++e)
#pragma unroll
            for (int r = 0; r < 16; ++r) { const float d = st.o[e][r] * inv - comb[(e * 16 + r) * 64 + lane]; st.o[e][r] = d; ss += d * d; }
        ss += __shfl_xor(ss, 32);
        const float rms = __builtin_amdgcn_rsqf(ss * (1.0f / 128.0f) + EPS) * 0.8f;
        const float* gs = A.in[15];
        bf16_t* orow = (bf16_t*)A.out + rowq * (2 * DM) + DM + h * 128;
#pragma unroll
        for (int e = 0; e < 4; ++e)
#pragma unroll
            for (int rr = 0; rr < 4; ++rr) {
                const int e0 = 32 * e + 8 * rr + 4 * hi;
                const f32x4 gv = *(const f32x4*)(gs + e0);
                u32x2 w; w.x = pk2(st.o[e][4 * rr] * rms * gv[0], st.o[e][4 * rr + 1] * rms * gv[1]); w.y = pk2(st.o[e][4 * rr + 2] * rms * gv[2], st.o[e][4 * rr + 3] * rms * gv[3]);
                *(u32x2*)(orow + e0) = w;
            }
    }
    __syncthreads();
}

#define RLX_AGENT __ATOMIC_RELAXED, __HIP_MEMORY_SCOPE_AGENT
#define XB_TMO      128
#define XB_XCNT(j)  (256  + 64 * (j))
#define XB_XSUB(j)  (1280 + 64 * (j))
#define XB_XGEN(j)  (2304 + 64 * (j))
#define XB_TOP      3328
#define XB_TOPGEN   3392
#define XCD_BAR_WORDS 3456
#define XB_SPIN_CAP (1u << 18)

__device__ __forceinline__ unsigned xb_ld(unsigned* p)              { return __hip_atomic_load(p, __ATOMIC_RELAXED, __HIP_MEMORY_SCOPE_AGENT); }
__device__ __forceinline__ unsigned xb_add(unsigned* p, unsigned v) { return __hip_atomic_fetch_add(p, v, __ATOMIC_RELAXED, __HIP_MEMORY_SCOPE_AGENT); }
__device__ __forceinline__ unsigned xb_xcc_id() { return (unsigned)__builtin_amdgcn_s_getreg((3 << 11) | 20) & 0xFu; }
#define XB_SPIN(cond, bar) do { unsigned _sp = 0; while (cond) { __builtin_amdgcn_s_sleep(1); \
    if ((++_sp & 255u) == 0u) { if (xb_ld(&(bar)[XB_TMO])) break; if (_sp > XB_SPIN_CAP) { atomicAdd(&(bar)[XB_TMO], 1u); break; } } } } while (0)

struct XcdBarrier {
    unsigned* bar; unsigned x;
    volatile LAS unsigned* st;
};

__device__ __forceinline__ XcdBarrier xcd_barrier_post(unsigned* bar, volatile LAS unsigned* st) {
    XcdBarrier b; b.bar = bar; b.x = xb_xcc_id(); b.st = st;
    if (threadIdx.x == 0) (void)xb_add(&bar[XB_XCNT(b.x)], 1u);
    return b;
}
__device__ __forceinline__ void xcd_barrier_complete(unsigned* bar, unsigned x, unsigned& nloc, unsigned& nx) {
    const unsigned G = gridDim.x * gridDim.y * gridDim.z;
    unsigned sum, cnt, mine, sp = 0u;
    for (;;) {
        sum = 0u; cnt = 0u; mine = 0u;
#pragma unroll
        for (unsigned j = 0; j < 16; ++j) { const unsigned c = xb_ld(&bar[XB_XCNT(j)]); sum += c; cnt += (c > 0u) ? 1u : 0u; mine = (j == x) ? c : mine; }
        if (sum == G) break;
        __builtin_amdgcn_s_sleep(1);
        if ((++sp & 255u) == 0u) { if (xb_ld(&bar[XB_TMO])) break; if (sp > XB_SPIN_CAP) { atomicAdd(&bar[XB_TMO], 1u); break; } }
    }
    nloc = mine > 0u ? mine : 1u; nx = cnt > 0u ? cnt : 1u;
}

__device__ __forceinline__ void xcd_barrier(const XcdBarrier& b) {
    asm volatile("s_waitcnt vmcnt(0)" ::: "memory");
    __syncthreads();
    if (threadIdx.x == 0) {
        unsigned* bar = b.bar;
        __builtin_amdgcn_s_waitcnt(0);
        unsigned nloc = b.st[0], nx = b.st[1];
        if (nloc == 0u) { xcd_barrier_complete(bar, b.x, nloc, nx); b.st[0] = nloc; b.st[1] = nx; }
        const unsigned old = xb_add(&bar[XB_XSUB(b.x)], 1u);
        const unsigned gen = old / nloc;
        if (old + 1u == (gen + 1u) * nloc) {
            __builtin_amdgcn_fence(__ATOMIC_RELEASE, "agent");
            asm volatile("s_waitcnt vmcnt(0)" ::: "memory");
            const unsigned og = xb_add(&bar[XB_TOP], 1u);
            const unsigned tg = og / nx;
            if (og + 1u == (tg + 1u) * nx) xb_add(&bar[XB_TOPGEN], 1u);
            else XB_SPIN(xb_ld(&bar[XB_TOPGEN]) == tg, bar);
            __builtin_amdgcn_fence(__ATOMIC_ACQUIRE, "agent");
            xb_add(&bar[XB_XGEN(b.x)], 1u);
            asm volatile("s_waitcnt vmcnt(0)" ::: "memory");
        } else {
            XB_SPIN(xb_ld(&bar[XB_XGEN(b.x)]) == gen, bar);
            __builtin_amdgcn_fence(__ATOMIC_ACQUIRE, "agent");
            asm volatile("s_waitcnt vmcnt(0)" ::: "memory");
        }
    }
    __syncthreads();
}


__global__ void __launch_bounds__(512, 2) fwd_megakernel(Args A) {
    extern __shared__ __attribute__((aligned(16))) unsigned char lds_raw[];
    LAS unsigned char* lds = (LAS unsigned char*)lds_raw;
    cg::grid_group grid = cg::this_grid();
    { volatile LAS unsigned* m0 = (volatile LAS unsigned*)(lds + MISC_OFF); if (threadIdx.x < 16) m0[threadIdx.x] = 0u; }
    __syncthreads();
    const XcdBarrier xbar = xcd_barrier_post((unsigned*)(A.ws + WS_CTL) + 4096 + 4096 * A.pad, (volatile LAS unsigned*)(lds + MISC_OFF) + 8);
    const int tid = threadIdx.x, lane = tid & 63, wave = __builtin_amdgcn_readfirstlane(tid >> 6);
    const int G = gridDim.x;
    unsigned char* ws = A.ws;
    bf16_t* SEG0 = (bf16_t*)(ws + WS_SEG);
    float* PART1 = (float*)(ws + WS_PART1); float* PART2 = (float*)(ws + WS_PART2);

    if (A.mask & 1) { p0_prologue(A, lds, tid, lane, wave);
    xcd_barrier(xbar); }
    if (A.mask < 0) grid.sync();

    if (A.mask & 2) { pg8::Gemm g{(const bf16_t*)A.out, (const bf16_t*)(ws + WS_WIN), MTOT, INCOLS, DM}; pg8::StaticOrder S; S.init(MTOT, INCOLS, G, (int)blockIdx.x);
      EpiProj E{SEG0, (const float*)(ws + WS_COS), (const float*)(ws + WS_SIN)};
      pg8::gemm_phase<EpiProj, pg8::StaticOrder, true, true>(lds, g, S, E);
    xcd_barrier(xbar); }

    if (A.mask & 4) {
        const float lam = ((const float*)(ws + WS_CTL))[64];
        const unsigned xcd = ((unsigned)__builtin_amdgcn_s_getreg((3 << 11) | 20) & 0xFu) & 7u;
        volatile LAS int* misc = (volatile LAS int*)(lds + MISC_OFF);
        constexpr int NSCAN_X = NB * 8 / 8, NATT_X = NB * 8 * 32 / 8;
        for (;;) {
            if (tid == 0) {
                int q = misc[1], v = -1;
                while (q < 8) {
                    const int xq = (int)((xcd + (unsigned)q) & 7u);
                    const int it = (int)atomicAdd((unsigned*)(ws + WS_CTL) + 128 + 64 * xq + 1024 * A.pad, 1u);
                    if (it < NSCAN_X + NATT_X) { v = (xq << 16) | it; break; }
                    ++q;
                }
                misc[1] = q; misc[0] = v;
            }
            __syncthreads();
            const int v = misc[0];
            __syncthreads();
            if (v < 0) break;
            const int xq = v >> 16, it = v & 0xffff;
            if (it < NSCAN_X) { const int si = xq * NSCAN_X + it; scan_item(si >> 3, si & 7, A, lds); }
            else { const int a = it - NSCAN_X; const int qb = 31 - (a & 31), bh = xq * 16 + (a >> 5); attn_unit(bh >> 3, bh & 7, qb, A, lam, lds); }
        }
    xcd_barrier(xbar); }

    if (A.mask & 8) {
    { pg8::Gemm g{(const bf16_t*)A.out, (const bf16_t*)(ws + WS_WRNN), MREAL, DM, 2 * DM}; pg8::StaticOrder S; S.init(MREAL, DM, G, (int)blockIdx.x);
      EpiMerge E{SEG0, SEG0 + 5 * SEG_ELEMS, SEG0 + 6 * SEG_ELEMS};
      pg8::gemm_phase<EpiMerge, pg8::StaticOrder, true, true>(lds, g, S, E); }
    xcd_barrier(xbar); }

    if (A.mask & 16) { pg8::Gemm g{SEG0, (const bf16_t*)(ws + WS_WO), MREAL, DM, DM}; pg8::StaticOrder S; S.init(MREAL, DM, G, (int)blockIdx.x);
      EpiRes<true> E{A.in[0], nullptr, SEG0 + 6 * SEG_ELEMS, SEG0 + 1 * SEG_ELEMS, A.in[19], PART1};
      pg8::gemm_phase<EpiRes<true>, pg8::StaticOrder, true, true>(lds, g, S, E);
    xcd_barrier(xbar); }

    if (A.mask & 32) { pg8::Gemm g{SEG0 + 1 * SEG_ELEMS, (const bf16_t*)(ws + WS_W1), MREAL, DFF, DM}; pg8::StaticOrder S; S.init(MREAL, DFF, G, (int)blockIdx.x);
      EpiFF1 E{SEG0 + 2 * SEG_ELEMS, PART1};
      pg8::gemm_phase<EpiFF1, pg8::StaticOrder, true, true>(lds, g, S, E);
    xcd_barrier(xbar); }

    if (A.mask & 64) { pg8::Gemm g{SEG0 + 2 * SEG_ELEMS, (const bf16_t*)(ws + WS_W2), MREAL, DM, DFF}; pg8::StaticOrder S; S.init(MREAL, DM, G, (int)blockIdx.x);
      EpiRes<false> E{nullptr, SEG0 + 6 * SEG_ELEMS, SEG0, nullptr, nullptr, PART2};
      pg8::gemm_phase<EpiRes<false>, pg8::StaticOrder, true, true>(lds, g, S, E);
    xcd_barrier(xbar);

    {
        const int gw = blockIdx.x * 8 + wave, NGW = G * 8;
        const f32x4* gf = (const f32x4*)A.in[22] + lane;
        f32x4 gv[4];
#pragma unroll
        for (int j = 0; j < 4; ++j) gv[j] = gf[64 * j];
        for (int m0 = gw; m0 + 3 * NGW < MREAL; m0 += 4 * NGW) {
            float pv[4]; u32x2 p[4][4];
#pragma unroll
            for (int q = 0; q < 4; ++q) { const int mrow = m0 + q * NGW;
                pv[q] = (lane < 16) ? PART2[(size_t)mrow * 16 + lane] : 0.f;
                const u32x2* hrow = (const u32x2*)(SEG0 + (size_t)mrow * DM) + lane;
#pragma unroll
                for (int j = 0; j < 4; ++j) p[q][j] = __builtin_nontemporal_load(hrow + 64 * j); }
#pragma unroll
            for (int q = 0; q < 4; ++q) { const int mrow = m0 + q * NGW;
                const float rstd = 1.0f / sqrtf(wave_sum(pv[q]) * (1.0f / DM) + EPS);
                f32x4* orow = (f32x4*)(A.out + (size_t)mrow * DM) + lane;
#pragma unroll
                for (int j = 0; j < 4; ++j) { const f32x4 v = (f32x4){bflo(p[q][j].x), bfhi(p[q][j].x), bflo(p[q][j].y), bfhi(p[q][j].y)}; __builtin_nontemporal_store(v * rstd * gv[j], orow + 64 * j); } }
        }
        for (int mrow = ((MREAL / (4 * NGW)) * 4 * NGW) + gw; mrow < MREAL; mrow += NGW) {
            const float pv = (lane < 16) ? PART2[(size_t)mrow * 16 + lane] : 0.f;
            const float rstd = 1.0f / sqrtf(wave_sum(pv) * (1.0f / DM) + EPS);
            f32x4* orow = (f32x4*)(A.out + (size_t)mrow * DM) + lane; const u32x2* hrow = (const u32x2*)(SEG0 + (size_t)mrow * DM) + lane;
#pragma unroll
            for (int j = 0; j < 4; ++j) { const u32x2 pp = __builtin_nontemporal_load(hrow + 64 * j); const f32x4 v = (f32x4){bflo(pp.x), bfhi(pp.x), bflo(pp.y), bfhi(pp.y)}; __builtin_nontemporal_store(v * rstd * gv[j], orow + 64 * j); }
        }
    }
    }
}

#ifndef PHM_A
#define PHM_A 127
#endif
extern "C" void kernel_launch(void* const* d_in, const int* in_sizes, int n_in, void* d_out, int out_size, void* d_ws, size_t ws_size, hipStream_t stream) {
    static int grid = 0;
    if (grid == 0) {
        if (n_in != 23 || out_size != MREAL * DM || ws_size < WS_END) { fprintf(stderr, "kernel_launch: unexpected shapes: n_in %d out %d ws %zu (need %zu)\n", n_in, out_size, ws_size, (size_t)WS_END); grid = -1; return; }
        int dev = 0, cus = 0, per_cu = 0;
        hipGetDevice(&dev); hipDeviceGetAttribute(&cus, hipDeviceAttributeMultiprocessorCount, dev);
        hipFuncSetAttribute((const void*)fwd_megakernel, hipFuncAttributeMaxDynamicSharedMemorySize, LDS_BYTES);
        hipOccupancyMaxActiveBlocksPerMultiprocessor(&per_cu, (const void*)fwd_megakernel, 512, LDS_BYTES);
        if (per_cu < 1) per_cu = 1;
        (void)hipGetLastError();
        grid = cus * per_cu;
    }
    if (grid < 0) return;
    hipMemsetAsync((char*)d_ws + WS_CTL, 0, 65536, stream);
    Args a{};
    for (int i = 0; i < 23; ++i) a.in[i] = (const float*)d_in[i];
    a.out = (float*)d_out; a.ws = (unsigned char*)d_ws; a.mask = PHM_A; a.pad = 0;
    void* args[] = {&a};
    hipError_t e = hipLaunchCooperativeKernel((const void*)fwd_megakernel, dim3(grid), dim3(512), args, LDS_BYTES, stream);
#ifdef PHM_B
    a.mask = PHM_B; a.pad = 1;
    e = hipLaunchCooperativeKernel((const void*)fwd_megakernel, dim3(grid), dim3(512), args, LDS_BYTES, stream);
#endif
    if (e != hipSuccess) fprintf(stderr, "cooperative launch failed: %s (grid %d)\n", hipGetErrorString(e), grid);
}
```
